# Optimizing an MI355X kernel written in HIP

```python
import math
import jax, jax.numpy as jnp
from jax import lax
import numpy as np

D_MODEL = 1024
BATCH = 4
SEQ = 8192
DEPTH = 2

MIX_WIDTH = D_MODEL
A_HEADS = 6
A_QK_DIM = 32
A_V_DIM = 2 * A_QK_DIM
A_WIDTH = A_HEADS * A_V_DIM
POOL_WINDOWS = (2, 4, 8, 16)
POOL_GROUP_DIM = 64
POOL_GROUPS = len(POOL_WINDOWS)
POOL_WIDTH = POOL_GROUPS * POOL_GROUP_DIM
C_HEADS = 6
C_KV_GROUPS = 2
C_HEADS_PER_GROUP = C_HEADS // C_KV_GROUPS
C_HEAD_DIM = 64
C_WIDTH = C_HEADS * C_HEAD_DIM
C_KV_WIDTH = C_KV_GROUPS * C_HEAD_DIM
CMP_BLOCK = 32
CMP_STRIDE = 16
SEL_BLOCK = 64
N_SEL = 16
WINDOW = 512
N_BRANCH = 3
FORCED_SCORE = 1.0e4
D_FF = 4 * D_MODEL
ROPE_THETA = 10000.0
LN_EPS = 1e-5
RMS_EPS = 1e-6
ALPHA = (2 * DEPTH) ** 0.25
BETA = (8 * DEPTH) ** -0.25
Q_BLOCK = 128
NSA_Q_BLOCK = 64

IN_SPLITS = (A_HEADS * 2 * A_QK_DIM,
             A_HEADS * 2 * A_QK_DIM,
             A_WIDTH,
             POOL_WIDTH,
             C_WIDTH,
             C_KV_WIDTH, C_KV_WIDTH,
             C_KV_WIDTH, C_KV_WIDTH,
             C_KV_WIDTH, C_KV_WIDTH,
             C_HEADS * N_BRANCH)
N_IN = sum(IN_SPLITS)

kernel_name = "hymba_diffattn_pool_nsa_deepnorm"


def layer_norm(x, g, b):
    xf = x.astype(jnp.float32)
    mu = jnp.mean(xf, -1, keepdims=True)
    var = jnp.mean(jnp.square(xf - mu), -1, keepdims=True)
    y = (xf - mu) * lax.rsqrt(var + LN_EPS) * g.astype(jnp.float32) + b.astype(jnp.float32)
    return y.astype(x.dtype)


def rope_tables(seq, dim):
    inv = 1.0 / (ROPE_THETA ** (jnp.arange(0, dim, 2, dtype=jnp.float32) / dim))
    ang = jnp.arange(seq, dtype=jnp.float32)[:, None] * inv[None, :]
    return jnp.cos(ang), jnp.sin(ang)


def apply_rope(x, cos, sin):
    xf = x.astype(jnp.float32)
    x1, x2 = jnp.split(xf, 2, axis=-1)
    return jnp.concatenate([x1 * cos - x2 * sin, x2 * cos + x1 * sin], -1).astype(x.dtype)


def masked_softmax(sc, mask):
    sc = sc.astype(jnp.float32)
    p = jax.nn.softmax(jnp.where(mask, sc, -1e30), axis=-1)
    return jnp.where(mask, p, 0.0)


def diff_attention(q1, q2, k1, k2, v, lam, lam_init, subln_g):
    B, H, T, dq = q1.shape
    scale = dq ** -0.5
    kpos = jnp.arange(T)

    def block(i):
        s = i * Q_BLOCK
        qpos = s + jnp.arange(Q_BLOCK)
        mask = kpos[None, :] <= qpos[:, None]

        def probs(q, k):
            qb = lax.dynamic_slice_in_dim(q, s, Q_BLOCK, axis=2)
            sc = jnp.einsum('bhqd,bhkd->bhqk', qb, k).astype(jnp.float32) * scale
            return jax.nn.softmax(jnp.where(mask, sc, -jnp.inf), axis=-1)

        p = probs(q1, k1) - lam * probs(q2, k2)
        return jnp.einsum('bhqk,bhkd->bhqd', p.astype(v.dtype), v)

    o = lax.map(block, jnp.arange(T // Q_BLOCK))
    o = jnp.transpose(o, (1, 0, 3, 2, 4)).reshape(B, T, H, -1)
    of = o.astype(jnp.float32)
    of = of * lax.rsqrt(jnp.mean(jnp.square(of), -1, keepdims=True) + RMS_EPS)
    of = of * subln_g.astype(jnp.float32) * (1.0 - lam_init)
    return of.reshape(B, T, -1).astype(v.dtype)


def pool_mixer(u, w_pool, pool_scale):
    B, T, _ = u.shape
    uf = u.astype(jnp.float32).reshape(B, T, POOL_GROUPS, POOL_GROUP_DIM)
    csum = jnp.pad(jnp.cumsum(uf, axis=1), ((0, 0), (1, 0), (0, 0), (0, 0)))
    t = jnp.arange(T)
    means = []
    for g, w in enumerate(POOL_WINDOWS):
        lo = jnp.maximum(t + 1 - w, 0)
        cnt = jnp.minimum(t + 1, w).astype(jnp.float32)
        means.append((csum[:, 1:, g] - csum[:, lo, g]) / cnt[None, :, None])
    y = jnp.stack(means, axis=2) - uf
    y = jnp.einsum('btgc,gcd->btgd', y, w_pool.astype(jnp.float32))
    y = y.reshape(B, T, POOL_WIDTH) * pool_scale.astype(jnp.float32)
    return y.astype(u.dtype)


def _gather_blocks(blocks, idx):
    return blocks[idx]


def nsa_attention(q, k_cmp, v_cmp, k_slc, v_slc, k_win, v_win, gates,
                  pe_k, pe_v, w_ck, w_cv):
    B, G, h, T, d = q.shape
    scale = d ** -0.5
    n_cmp = (T - CMP_BLOCK) // CMP_STRIDE + 1
    cmp_start = jnp.arange(n_cmp) * CMP_STRIDE
    cmp_idx = cmp_start[:, None] + jnp.arange(CMP_BLOCK)[None, :]
    kc = jnp.einsum('bgnld,lde->bgne', k_cmp[:, :, cmp_idx] + pe_k, w_ck)
    vc = jnp.einsum('bgnld,lde->bgne', v_cmp[:, :, cmp_idx] + pe_v, w_cv)
    cmp_end = cmp_start + CMP_BLOCK - 1
    n_blk = T // SEL_BLOCK
    n_sel = min(N_SEL, n_blk)
    blk_start = jnp.arange(n_blk) * SEL_BLOCK
    overlap = ((cmp_start[:, None] < blk_start[None, :] + SEL_BLOCK)
               & (cmp_start[:, None] + CMP_BLOCK > blk_start[None, :])).astype(jnp.float32)
    k_blocks = k_slc.reshape(B, G, n_blk, SEL_BLOCK, d)
    v_blocks = v_slc.reshape(B, G, n_blk, SEL_BLOCK, d)
    gather = jax.vmap(jax.vmap(_gather_blocks))
    pad = ((0, 0), (0, 0), (WINDOW, 0), (0, 0))
    k_win_p = jnp.pad(k_win, pad)
    v_win_p = jnp.pad(v_win, pad)
    blk_ids = jnp.arange(n_blk)[None, :]

    def block(i):
        s = i * NSA_Q_BLOCK
        t = s + jnp.arange(NSA_Q_BLOCK)
        qb = lax.dynamic_slice_in_dim(q, s, NSA_Q_BLOCK, axis=3)
        cmask = cmp_end[None, :] <= t[:, None]
        p_cmp = masked_softmax(jnp.einsum('bghqd,bgnd->bghqn', qb, kc) * scale, cmask)
        o_cmp = jnp.einsum('bghqn,bgnd->bghqd', p_cmp.astype(vc.dtype), vc)
        imp = jnp.einsum('bghqn,ns->bgqs', p_cmp, overlap)
        cur = (t // SEL_BLOCK)[:, None]
        forced = (blk_ids == 0) | (blk_ids == cur) | (blk_ids == cur - 1)
        imp = jnp.where(forced, FORCED_SCORE, imp)
        imp = jnp.where(blk_ids > cur, -1.0, imp)
        _, sel = lax.top_k(imp, n_sel)
        ks = gather(k_blocks, sel).reshape(B, G, NSA_Q_BLOCK, n_sel * SEL_BLOCK, d)
        vs = gather(v_blocks, sel).reshape(B, G, NSA_Q_BLOCK, n_sel * SEL_BLOCK, d)
        kpos = (sel[..., None] * SEL_BLOCK + jnp.arange(SEL_BLOCK)).reshape(
            B, G, NSA_Q_BLOCK, n_sel * SEL_BLOCK)
        smask = (kpos <= t[None, None, :, None])[:, :, None]
        p_slc = masked_softmax(jnp.einsum('bghqd,bgqkd->bghqk', qb, ks) * scale, smask)
        o_slc = jnp.einsum('bghqk,bgqkd->bghqd', p_slc.astype(vs.dtype), vs)
        kw = lax.dynamic_slice_in_dim(k_win_p, s, WINDOW + NSA_Q_BLOCK, axis=2)
        vw = lax.dynamic_slice_in_dim(v_win_p, s, WINDOW + NSA_Q_BLOCK, axis=2)
        wpos = s - WINDOW + jnp.arange(WINDOW + NSA_Q_BLOCK)
        wmask = ((wpos[None, :] <= t[:, None]) & (wpos[None, :] > t[:, None] - WINDOW)
                 & (wpos[None, :] >= 0))
        p_win = masked_softmax(jnp.einsum('bghqd,bgkd->bghqk', qb, kw) * scale, wmask)
        o_win = jnp.einsum('bghqk,bgkd->bghqd', p_win.astype(vw.dtype), vw)
        return jnp.stack([o_cmp, o_slc, o_win], axis=-1)

    o = lax.map(block, jnp.arange(T // NSA_Q_BLOCK))
    o = jnp.transpose(o, (1, 0, 4, 2, 3, 5, 6)).reshape(B, T, G, h, d, N_BRANCH)
    out = jnp.einsum('btghdr,btghr->btghd', o, gates)
    return out.reshape(B, T, G * h * d)


def _to_kv(z, B, T):
    return z.reshape(B, T, C_KV_GROUPS, C_HEAD_DIM).transpose(0, 2, 1, 3)


def setup_inputs(seed: int = 0) -> dict:
    key = jax.random.key(seed)
    ks = jax.random.split(key, 22)

    def nrm(k, shape, s):
        return jax.random.normal(k, shape, jnp.float32) * s

    return {
        'x': nrm(ks[0], (BATCH, SEQ, D_MODEL), 1.0),
        'w_in': nrm(ks[1], (DEPTH, D_MODEL, N_IN), D_MODEL ** -0.5),
        'lam_q1': nrm(ks[2], (DEPTH, A_QK_DIM), 0.1),
        'lam_k1': nrm(ks[3], (DEPTH, A_QK_DIM), 0.1),
        'lam_q2': nrm(ks[4], (DEPTH, A_QK_DIM), 0.1),
        'lam_k2': nrm(ks[5], (DEPTH, A_QK_DIM), 0.1),
        'subln_g': 1.0 + nrm(ks[6], (DEPTH, A_V_DIM), 0.02),
        'w_pool': nrm(ks[7], (DEPTH, POOL_GROUPS, POOL_GROUP_DIM, POOL_GROUP_DIM), POOL_GROUP_DIM ** -0.5),
        'pool_scale': 1.0 + nrm(ks[8], (DEPTH, POOL_WIDTH), 0.1),
        'cmp_pe_k': nrm(ks[9], (DEPTH, CMP_BLOCK, C_HEAD_DIM), 0.1),
        'cmp_pe_v': nrm(ks[10], (DEPTH, CMP_BLOCK, C_HEAD_DIM), 0.1),
        'w_cmp_k': nrm(ks[11], (DEPTH, CMP_BLOCK, C_HEAD_DIM, C_HEAD_DIM), (CMP_BLOCK * C_HEAD_DIM) ** -0.5),
        'w_cmp_v': nrm(ks[12], (DEPTH, CMP_BLOCK, C_HEAD_DIM, C_HEAD_DIM), (CMP_BLOCK * C_HEAD_DIM) ** -0.5),
        'w_out': nrm(ks[13], (DEPTH, MIX_WIDTH, D_MODEL), BETA * MIX_WIDTH ** -0.5),
        'ln1_g': 1.0 + nrm(ks[14], (DEPTH, D_MODEL), 0.02),
        'ln1_b': nrm(ks[15], (DEPTH, D_MODEL), 0.02),
        'w_up': nrm(ks[16], (DEPTH, D_MODEL, D_FF), D_MODEL ** -0.5),
        'w_down': nrm(ks[17], (DEPTH, D_FF, D_MODEL), BETA * D_FF ** -0.5),
        'ln2_g': 1.0 + nrm(ks[18], (DEPTH, D_MODEL), 0.02),
        'ln2_b': nrm(ks[19], (DEPTH, D_MODEL), 0.02),
    }


def reference(x, w_in, lam_q1, lam_k1, lam_q2, lam_k2, subln_g, w_pool, pool_scale,
              cmp_pe_k, cmp_pe_v, w_cmp_k, w_cmp_v, w_out, ln1_g, ln1_b,
              w_up, w_down, ln2_g, ln2_b):
    B, T, _ = x.shape
    G, h = C_KV_GROUPS, C_HEADS_PER_GROUP
    cos_a, sin_a = rope_tables(T, A_QK_DIM)
    cos_c, sin_c = rope_tables(T, C_HEAD_DIM)
    offsets = np.cumsum(IN_SPLITS)[:-1].tolist()
    for l in range(DEPTH):
        lam_init = 0.8 - 0.6 * math.exp(-0.3 * l)
        proj = jnp.einsum('btd,dn->btn', x, w_in[l])
        (qa, ka, va, u, qc, kcm, vcm, ksl, vsl, kwi, vwi, gc) = jnp.split(proj, offsets, axis=-1)
        qa = apply_rope(qa.reshape(B, T, A_HEADS, 2, A_QK_DIM).transpose(0, 2, 3, 1, 4), cos_a, sin_a)
        ka = apply_rope(ka.reshape(B, T, A_HEADS, 2, A_QK_DIM).transpose(0, 2, 3, 1, 4), cos_a, sin_a)
        va = va.reshape(B, T, A_HEADS, A_V_DIM).transpose(0, 2, 1, 3)
        lam = (jnp.exp(jnp.sum(lam_q1[l].astype(jnp.float32) * lam_k1[l].astype(jnp.float32)))
               - jnp.exp(jnp.sum(lam_q2[l].astype(jnp.float32) * lam_k2[l].astype(jnp.float32)))
               + lam_init)
        o_a = diff_attention(qa[:, :, 0], qa[:, :, 1], ka[:, :, 0], ka[:, :, 1], va,
                             lam, lam_init, subln_g[l])
        o_b = pool_mixer(u, w_pool[l], pool_scale[l])
        qc = apply_rope(qc.reshape(B, T, G, h, C_HEAD_DIM).transpose(0, 2, 3, 1, 4), cos_c, sin_c)
        kcm = apply_rope(_to_kv(kcm, B, T), cos_c, sin_c)
        ksl = apply_rope(_to_kv(ksl, B, T), cos_c, sin_c)
        kwi = apply_rope(_to_kv(kwi, B, T), cos_c, sin_c)
        gates = jax.nn.sigmoid(gc.astype(jnp.float32)).astype(x.dtype).reshape(B, T, G, h, N_BRANCH)
        o_c = nsa_attention(qc, kcm, _to_kv(vcm, B, T), ksl, _to_kv(vsl, B, T),
                            kwi, _to_kv(vwi, B, T), gates,
                            cmp_pe_k[l], cmp_pe_v[l], w_cmp_k[l], w_cmp_v[l])
        mix = jnp.einsum('btm,md->btd', jnp.concatenate([o_a, o_b, o_c], axis=-1), w_out[l])
        x = layer_norm(ALPHA * x + mix, ln1_g[l], ln1_b[l])
        hid = jnp.square(jax.nn.relu(jnp.einsum('btd,df->btf', x, w_up[l])))
        x = layer_norm(ALPHA * x + jnp.einsum('btf,fd->btd', hid, w_down[l]), ln2_g[l], ln2_b[l])
    return x
```

```cpp
#include <hip/hip_runtime.h>
#include <hip/hip_cooperative_groups.h>
#include <math.h>
#include <cstdio>
namespace cg = cooperative_groups;

typedef unsigned short u16;
typedef __attribute__((ext_vector_type(8))) short bf16x8;
typedef __attribute__((ext_vector_type(4))) float f32x4;
typedef __attribute__((ext_vector_type(16))) float f32x16;

#define DEV __device__ __forceinline__
#ifndef COOP
#define COOP 1
#endif

constexpr int NB = 4, T = 8192, DM = 1024, MTOK = NB * T, NIN = 2578, NINP = 2688, DFF = 4096;
constexpr float ALPHA = 1.4142135623730951f;
constexpr float LOG2E = 1.4426950408889634f;
constexpr int SMEM_BYTES = 73728;

constexpr size_t OFF_WIN = 0;
constexpr size_t OFF_WOUT = OFF_WIN + (size_t)2 * NINP * 1024 * 2;
constexpr size_t OFF_WUP = OFF_WOUT + (size_t)2 * 1024 * 1024 * 2;
constexpr size_t OFF_WDOWN = OFF_WUP + (size_t)2 * 4096 * 1024 * 2;
constexpr size_t OFF_WCK = OFF_WDOWN + (size_t)2 * 4096 * 1024 * 2;
constexpr size_t OFF_WCV = OFF_WCK + (size_t)2 * 128 * 2048 * 2;
constexpr size_t OFF_SMALL = OFF_WCV + (size_t)2 * 128 * 2048 * 2;
constexpr size_t OFF_ROPEA = OFF_SMALL + 4096;
constexpr size_t OFF_ROPEC = OFF_ROPEA + (size_t)2 * T * 16 * 4;
constexpr size_t OFF_XB = OFF_ROPEC + (size_t)2 * T * 32 * 4;
constexpr size_t OFF_R = OFF_XB + (size_t)MTOK * 1024 * 2;
constexpr size_t OFF_QA = OFF_R;
constexpr size_t OFF_KA = OFF_QA + (size_t)NB * 12 * T * 32 * 2;
constexpr size_t OFF_VA = OFF_KA + (size_t)NB * 12 * T * 32 * 2;
constexpr size_t OFF_U = OFF_VA + (size_t)NB * 6 * T * 64 * 2;
constexpr size_t OFF_QC = OFF_U + (size_t)MTOK * 256 * 2;
constexpr size_t KVSZ = (size_t)NB * 2 * T * 64 * 2;
constexpr size_t OFF_KCM = OFF_QC + (size_t)NB * 6 * T * 64 * 2;
constexpr size_t OFF_VCM = OFF_KCM + KVSZ;
constexpr size_t OFF_KSL = OFF_VCM + KVSZ;
constexpr size_t OFF_VSL = OFF_KSL + KVSZ;
constexpr size_t OFF_KWI = OFF_VSL + KVSZ;
constexpr size_t OFF_VWI = OFF_KWI + KVSZ;
constexpr size_t OFF_GATES = OFF_VWI + KVSZ;
constexpr size_t OFF_KC = OFF_GATES + (size_t)MTOK * 18 * 4;
constexpr size_t OFF_VC = OFF_KC + (size_t)NB * 2 * 512 * 64 * 2;
constexpr size_t OFF_MIX = OFF_VC + (size_t)NB * 2 * 512 * 64 * 2;
constexpr size_t OFF_MIX_END = OFF_MIX + (size_t)MTOK * 1024 * 2;
constexpr size_t OFF_H = OFF_R;
constexpr size_t OFF_END = OFF_R + (size_t)MTOK * 4096 * 2;
static_assert(OFF_MIX_END <= OFF_END, "mixer buffers must fit in H region");

struct Params {
  const float *x, *w_in, *lq1, *lk1, *lq2, *lk2, *subln, *w_pool, *pool_scale, *pe_k, *pe_v, *w_ck, *w_cv,
      *w_out, *ln1g, *ln1b, *w_up, *w_down, *ln2g, *ln2b;
  float* out;
  char* ws;
  int pbeg, pend, coop, pad;
};

DEV int otid() { int t = threadIdx.x; asm volatile("" : "+v"(t)); return t; }
DEV unsigned pack2(float a, float b) {
  unsigned r;
  asm("v_cvt_pk_bf16_f32 %0, %1, %2" : "=v"(r) : "v"(a), "v"(b));
  return r;
}
DEV float bf2f(u16 h) { return __uint_as_float(((unsigned)h) << 16); }
DEV float bflo(unsigned w) { return __uint_as_float(w << 16); }
DEV float bfhi(unsigned w) { return __uint_as_float(w & 0xFFFF0000u); }
DEV float fexp2(float x) { return __builtin_amdgcn_exp2f(x); }
DEV uint4 pack8(const float* v) {
  uint4 r;
  r.x = pack2(v[0], v[1]); r.y = pack2(v[2], v[3]); r.z = pack2(v[4], v[5]); r.w = pack2(v[6], v[7]);
  return r;
}
DEV bf16x8 as_frag(uint4 v) {
  union { uint4 u; bf16x8 f; } c; c.u = v; return c.f;
}
DEV bf16x8 ldfrag(const u16* p) { return as_frag(*(const uint4*)p); }
DEV f32x4 mfma16(bf16x8 a, bf16x8 b, f32x4 c) { return __builtin_amdgcn_mfma_f32_16x16x32_bf16(a, b, c, 0, 0, 0); }
DEV float wsum(float v) {
#pragma unroll
  for (int o = 32; o >= 1; o >>= 1) v += __shfl_xor(v, o);
  return v;
}
DEV float gmax4(float v) {
  v = fmaxf(v, __shfl_xor(v, 16));
  v = fmaxf(v, __shfl_xor(v, 32));
  return v;
}
DEV float gsum4(float v) {
  v += __shfl_xor(v, 16);
  v += __shfl_xor(v, 32);
  return v;
}
DEV int rowmax_i(int v) {
  int t;
  t = __builtin_amdgcn_update_dpp(0, v, 0xB1, 0xF, 0xF, true); v = max(v, t);
  t = __builtin_amdgcn_update_dpp(0, v, 0x4E, 0xF, 0xF, true); v = max(v, t);
  t = __builtin_amdgcn_update_dpp(0, v, 0x141, 0xF, 0xF, true); v = max(v, t);
  t = __builtin_amdgcn_update_dpp(0, v, 0x140, 0xF, 0xF, true); v = max(v, t);
  return v;
}

DEV void gemm_mainloop(const u16* __restrict__ A, int lda, const u16* __restrict__ Bt, int ldb, int K, int m0, int n0,
                       char* smem) {
  const int tid = otid(), lane = tid & 63, wid = tid >> 6;
  const int wm = wid >> 1, wn = wid & 1;
  const int lr = tid >> 3, lc = tid & 7;
  const u16* ga = A + (size_t)(m0 + lr) * lda + lc * 8;
  const u16* gb = Bt + (size_t)(n0 + lr) * ldb + lc * 8;
  const size_t sa32 = (size_t)32 * lda, sb32 = (size_t)32 * ldb;
  uint4 ra[4], rb[4];
#pragma unroll
  for (int i = 0; i < 4; ++i) {
    ra[i] = *(const uint4*)(ga + i * sa32);
    rb[i] = *(const uint4*)(gb + i * sb32);
  }
  f32x16 acc[2][2];
#pragma unroll
  for (int i = 0; i < 2; ++i)
#pragma unroll
    for (int j = 0; j < 2; ++j)
#pragma unroll
      for (int r = 0; r < 16; ++r) acc[i][j][r] = 0.f;
  const int nk = K >> 6;
  {
    char* sA = smem;
    char* sB = smem + 18432;
#pragma unroll
    for (int i = 0; i < 4; ++i) {
      *(uint4*)(sA + (lr + 32 * i) * 144 + lc * 16) = ra[i];
      *(uint4*)(sB + (lr + 32 * i) * 144 + lc * 16) = rb[i];
    }
  }
  __syncthreads();
  const int frow = lane & 31, fk = (lane >> 5) * 16;
  for (int kt = 0; kt < nk; ++kt) {
    const int s = kt & 1;
    if (kt + 1 < nk) {
#pragma unroll
      for (int i = 0; i < 4; ++i) {
        ra[i] = *(const uint4*)(ga + i * sa32 + (kt + 1) * 64);
        rb[i] = *(const uint4*)(gb + i * sb32 + (kt + 1) * 64);
      }
    }
    const char* sA = smem + s * 36864;
    const char* sB = sA + 18432;
#pragma unroll
    for (int ks = 0; ks < 4; ++ks) {
      bf16x8 af[2], bfr[2];
#pragma unroll
      for (int i = 0; i < 2; ++i) af[i] = as_frag(*(const uint4*)(sA + (wm * 64 + i * 32 + frow) * 144 + ks * 32 + fk));
#pragma unroll
      for (int j = 0; j < 2; ++j) bfr[j] = as_frag(*(const uint4*)(sB + (wn * 64 + j * 32 + frow) * 144 + ks * 32 + fk));
#pragma unroll
      for (int i = 0; i < 2; ++i)
#pragma unroll
        for (int j = 0; j < 2; ++j) acc[i][j] = __builtin_amdgcn_mfma_f32_32x32x16_bf16(af[i], bfr[j], acc[i][j], 0, 0, 0);
    }
    if (kt + 1 < nk) {
      char* dA = smem + (s ^ 1) * 36864;
      char* dB = dA + 18432;
#pragma unroll
      for (int i = 0; i < 4; ++i) {
        *(uint4*)(dA + (lr + 32 * i) * 144 + lc * 16) = ra[i];
        *(uint4*)(dB + (lr + 32 * i) * 144 + lc * 16) = rb[i];
      }
    }
    __syncthreads();
  }
  float* sC = (float*)smem;
#pragma unroll
  for (int i = 0; i < 2; ++i)
#pragma unroll
    for (int j = 0; j < 2; ++j)
#pragma unroll
      for (int r = 0; r < 16; ++r) {
        int row = wm * 64 + i * 32 + (r & 3) + 8 * (r >> 2) + 4 * (lane >> 5);
        int col = wn * 64 + j * 32 + (lane & 31);
        sC[row * 132 + col] = acc[i][j][r];
      }
  __syncthreads();
}

DEV int kfrag_lane(int tk, int g4) { return ((tk >> 3) << 2) + (tk & 3) + 16 * g4; }

DEV void transpose_mat(const float* __restrict__ src, u16* __restrict__ dst, int K, int N, int Npad, char* smem) {
  float* tl = (float*)smem;
  const int tid = otid();
  const int tn = Npad >> 6, ntile = (K >> 6) * tn;
  for (int tile = blockIdx.x; tile < ntile; tile += gridDim.x) {
    const int k0 = (tile / tn) << 6, n0 = (tile % tn) << 6;
#pragma unroll 4
    for (int i = 0; i < 16; ++i) {
      int r = (tid >> 6) + 4 * i, c = tid & 63, n = n0 + c;
      tl[r * 65 + c] = (n < N) ? src[(size_t)(k0 + r) * N + n] : 0.f;
    }
    __syncthreads();
#pragma unroll
    for (int j = 0; j < 2; ++j) {
      int ch = tid + 256 * j, n = ch >> 3, kc = ch & 7;
      float v[8];
#pragma unroll
      for (int e = 0; e < 8; ++e) v[e] = tl[(kc * 8 + e) * 65 + n];
      *(uint4*)(dst + (size_t)(n0 + n) * K + k0 + kc * 8) = pack8(v);
    }
    __syncthreads();
  }
}

DEV void sincos_d(double x, double& s, double& c) {
  const double TWO_OVER_PI = 0.63661977236758134308;
  const double PIO2_HI = 1.57079632679489655800e+00, PIO2_LO = 6.12323399573676603587e-17;
  double kd = rint(x * TWO_OVER_PI);
  double r = (x - kd * PIO2_HI) - kd * PIO2_LO;
  double r2 = r * r;
  double sp = r * (1.0 + r2 * (-1.0 / 6 + r2 * (1.0 / 120 + r2 * (-1.0 / 5040 + r2 * (1.0 / 362880 + r2 * (-1.0 / 39916800 + r2 * (1.0 / 6227020800.0)))))));
  double cp = 1.0 + r2 * (-0.5 + r2 * (1.0 / 24 + r2 * (-1.0 / 720 + r2 * (1.0 / 40320 + r2 * (-1.0 / 3628800 + r2 * (1.0 / 479001600 + r2 * (-1.0 / 87178291200.0)))))));
  int k = ((int)kd) & 3;
  s = (k == 0) ? sp : (k == 1) ? cp : (k == 2) ? -sp : -cp;
  c = (k == 0) ? cp : (k == 1) ? -sp : (k == 2) ? -cp : sp;
}

DEV void phase_prep(const Params& p, char* smem) {
  const int tid = otid();
  char* ws = p.ws;
  for (int id = 0; id < 12; ++id) {
    const int l = id / 6, k = id % 6;
    const float* src; u16* dst; int K, N, Npad;
    if (k == 0) { src = p.w_in + (size_t)l * 1024 * NIN; dst = (u16*)(ws + OFF_WIN) + (size_t)l * NINP * 1024; K = 1024; N = NIN; Npad = NINP; }
    else if (k == 1) { src = p.w_out + (size_t)l * 1024 * 1024; dst = (u16*)(ws + OFF_WOUT) + (size_t)l * 1024 * 1024; K = 1024; N = 1024; Npad = 1024; }
    else if (k == 2) { src = p.w_up + (size_t)l * 1024 * 4096; dst = (u16*)(ws + OFF_WUP) + (size_t)l * 4096 * 1024; K = 1024; N = 4096; Npad = 4096; }
    else if (k == 3) { src = p.w_down + (size_t)l * 4096 * 1024; dst = (u16*)(ws + OFF_WDOWN) + (size_t)l * 4096 * 1024; K = 4096; N = 1024; Npad = 1024; }
    else if (k == 4) { src = p.w_ck + (size_t)l * 2048 * 64; dst = (u16*)(ws + OFF_WCK) + (size_t)l * 128 * 2048; K = 2048; N = 64; Npad = 128; }
    else { src = p.w_cv + (size_t)l * 2048 * 64; dst = (u16*)(ws + OFF_WCV) + (size_t)l * 128 * 2048; K = 2048; N = 64; Npad = 128; }
    transpose_mat(src, dst, K, N, Npad, smem);
  }
  const size_t gtid = (size_t)blockIdx.x * 256 + tid, gstride = (size_t)gridDim.x * 256;
  {
    const float4* x4 = (const float4*)p.x;
    uint2* xb = (uint2*)(ws + OFF_XB);
    for (size_t i = gtid; i < (size_t)MTOK * 1024 / 4; i += gstride) {
      float4 v = x4[i];
      uint2 o; o.x = pack2(v.x, v.y); o.y = pack2(v.z, v.w);
      xb[i] = o;
    }
  }
  {
    float* cA = (float*)(ws + OFF_ROPEA); float* sA = cA + T * 16;
    float* cC = (float*)(ws + OFF_ROPEC); float* sCc = cC + T * 32;
    for (size_t i = gtid; i < (size_t)T * 48; i += gstride) {
      int t = (int)(i / 48), jj = (int)(i % 48);
      int j32 = (jj < 16) ? 2 * jj : (jj - 16);
      double inv = 1.0;
      const double base = 0.7498942093324559;
      for (int q = 0; q < j32; ++q) inv *= base;
      double s, c;
      sincos_d((double)t * inv, s, c);
      if (jj < 16) { cA[t * 16 + jj] = (float)c; sA[t * 16 + jj] = (float)s; }
      else { cC[t * 32 + jj - 16] = (float)c; sCc[t * 32 + jj - 16] = (float)s; }
    }
  }
  float* small = (float*)(ws + OFF_SMALL);
  if (blockIdx.x < 4) {
    const int l = blockIdx.x >> 1, kv = blockIdx.x & 1;
    const float* pe = (kv ? p.pe_v : p.pe_k) + (size_t)l * 2048;
    const float* w = (kv ? p.w_cv : p.w_ck) + (size_t)l * 2048 * 64;
    const int e = tid & 63, part = tid >> 6;
    float acc = 0.f;
    for (int i = part * 512; i < part * 512 + 512; ++i) acc += pe[i] * w[(size_t)i * 64 + e];
    float* red = (float*)smem;
    red[tid] = acc;
    __syncthreads();
    if (tid < 64) small[kv * 128 + l * 64 + tid] = red[tid] + red[tid + 64] + red[tid + 128] + red[tid + 192];
    __syncthreads();
  }
  if (blockIdx.x == 0 && tid == 0) {
    for (int l = 0; l < 2; ++l) {
      float a = 0.f, b = 0.f;
      for (int i = 0; i < 32; ++i) { a += p.lq1[l * 32 + i] * p.lk1[l * 32 + i]; b += p.lq2[l * 32 + i] * p.lk2[l * 32 + i]; }
      float lam_init = 0.8f - 0.6f * expf(-0.3f * l);
      small[256 + l] = expf(a) - expf(b) + lam_init;
    }
    int* ctr = (int*)(small + 260);
    for (int i = 0; i < 8; ++i) ctr[i] = 0;
  }
}

DEV void phase_inproj(const Params& p, int layer, char* smem) {
  char* ws = p.ws;
  const int tid = otid();
  const u16* A = (const u16*)(ws + OFF_XB);
  const u16* Bt = (const u16*)(ws + OFF_WIN) + (size_t)layer * NINP * 1024;
  const float* cA = (const float*)(ws + OFF_ROPEA); const float* sA = cA + T * 16;
  const float* cC = (const float*)(ws + OFF_ROPEC); const float* sCc = cC + T * 32;
  const float* sC = (const float*)smem;
  const int ntiles = (MTOK / 128) * 21;
  for (int tile = blockIdx.x; tile < ntiles; tile += gridDim.x) {
    const int tn = tile % 21, tm = tile / 21;
    const int m0 = tm * 128, n0 = tn * 128;
    gemm_mainloop(A, 1024, Bt, 1024, 1024, m0, n0, smem);
    const int b = m0 >> 13, t0 = m0 & (T - 1);
    if (tn == 20) {
      float* G = (float*)(ws + OFF_GATES);
      for (int u = tid; u < 128 * 18; u += 256) {
        int r = u / 18, c = u % 18;
        float v = sC[r * 132 + c];
        G[(size_t)(m0 + r) * 18 + c] = 1.f / (1.f + __expf(-v));
      }
    } else if ((tn >= 6 && tn <= 8) || tn == 15 || tn == 17 || tn == 19) {
      if (tn == 15) {
        u16* dst = (u16*)(ws + OFF_VCM);
        for (int u = tid; u < 2048; u += 256) {
          int r = u >> 4, c8 = u & 15, cc0 = c8 * 8;
          float v[8];
#pragma unroll
          for (int e = 0; e < 8; ++e) v[e] = sC[r * 132 + cc0 + e];
          int g = cc0 >> 6, d0 = cc0 & 63;
          *(uint4*)(dst + (((size_t)(b * 2 + g) * T + t0 + r) * 64 + d0)) = pack8(v);
        }
      } else {
        u16* dst; int hb, nh;
        if (tn <= 8) { dst = (u16*)(ws + OFF_VA); hb = (tn - 6) * 2; nh = 6; }
        else if (tn == 17) { dst = (u16*)(ws + OFF_VSL); hb = 0; nh = 2; }
        else { dst = (u16*)(ws + OFF_VWI); hb = 0; nh = 2; }
        for (int u = tid; u < 2048; u += 256) {
          int tg = u >> 7, col = u & 127;
          float v[8];
#pragma unroll
          for (int e = 0; e < 8; ++e) v[e] = sC[(tg * 8 + e) * 132 + col];
          int h = hb + (col >> 6), d = col & 63;
          int t = t0 + tg * 8;
          int G = t >> 5, g4 = (t & 31) >> 3;
          size_t off = ((size_t)(b * nh + h) * 256 + G) * 2048 + ((d >> 4) * 64 + (d & 15) + 16 * g4) * 8;
          *(uint4*)(dst + off) = pack8(v);
        }
      }
    } else {
      int HD = 0; float scale = 1.f;
      if (tn <= 5) HD = 32;
      else if (tn >= 11 && tn != 15) HD = 64;
      if (tn <= 2) scale = 0.17677669529663687f * LOG2E;
      if (tn >= 11 && tn <= 13) scale = 0.125f * LOG2E;
      const float* ct = (HD == 32) ? cA : cC;
      const float* st = (HD == 32) ? sA : sCc;
      for (int u = tid; u < 2048; u += 256) {
        int r = u >> 4, c8 = u & 15, cc0 = c8 * 8;
        int t = t0 + r;
        float v[8];
#pragma unroll
        for (int e = 0; e < 8; ++e) v[e] = sC[r * 132 + cc0 + e];
        if (HD) {
          int half = HD >> 1;
          int d0 = cc0 & (HD - 1);
          bool lo = d0 < half;
          int j0 = d0 & (half - 1);
          const float* pp = sC + r * 132 + (lo ? cc0 + half : cc0 - half);
          const float* cs = ct + (size_t)t * half + j0;
          const float* sn = st + (size_t)t * half + j0;
#pragma unroll
          for (int e = 0; e < 8; ++e) {
            float c = cs[e], s = sn[e], pv = pp[e];
            v[e] = lo ? (v[e] * c - pv * s) : (v[e] * c + pv * s);
          }
        }
#pragma unroll
        for (int e = 0; e < 8; ++e) v[e] *= scale;
        uint4 o = pack8(v);
        int tk = t & 31, G = t >> 5, uu = (tk >> 2) & 1;
        if (tn <= 2) {
          int hm = tn * 4 + (cc0 >> 5), d0 = cc0 & 31;
          *(uint4*)((u16*)(ws + OFF_QA) + (((size_t)(b * 12 + hm) * T + t) * 32 + d0)) = o;
        } else if (tn <= 5) {
          int hm = (tn - 3) * 4 + (cc0 >> 5), d0 = cc0 & 31;
          size_t off = ((size_t)(b * 12 + hm) * 256 + G) * 1024 + (uu * 64 + kfrag_lane(tk, d0 >> 3)) * 8;
          *(uint4*)((u16*)(ws + OFF_KA) + off) = o;
        } else if (tn <= 10) {
          *(uint4*)((u16*)(ws + OFF_U) + ((size_t)(m0 + r) * 256 + (n0 - 1152) + cc0)) = o;
        } else if (tn <= 13) {
          int hh = (tn - 11) * 2 + (cc0 >> 6), d0 = cc0 & 63;
          *(uint4*)((u16*)(ws + OFF_QC) + (((size_t)(b * 6 + hh) * T + t) * 64 + d0)) = o;
        } else if (tn == 14) {
          int g = cc0 >> 6, d0 = cc0 & 63;
          *(uint4*)((u16*)(ws + OFF_KCM) + (((size_t)(b * 2 + g) * T + t) * 64 + d0)) = o;
        } else {
          u16* dst = (u16*)(ws + (tn == 16 ? OFF_KSL : OFF_KWI));
          int g = cc0 >> 6, d0 = cc0 & 63;
          size_t off = ((size_t)(b * 2 + g) * 256 + G) * 2048 + (((d0 >> 5) * 2 + uu) * 64 + kfrag_lane(tk, (d0 >> 3) & 3)) * 8;
          *(uint4*)(dst + off) = o;
        }
      }
    }
    __syncthreads();
  }
}

DEV void phase_compress(const Params& p, int layer, char* smem) {
  char* ws = p.ws;
  const int tid = otid();
  const float* sC = (const float*)smem;
  const float* small = (const float*)(ws + OFF_SMALL);
  for (int item = blockIdx.x; item < 64; item += gridDim.x) {
    const int kv = item >> 5, bg = (item >> 2) & 7, mt = item & 3;
    const u16* A = (const u16*)(ws + (kv ? OFF_VCM : OFF_KCM)) + (size_t)bg * T * 64;
    const u16* Bt = (const u16*)(ws + (kv ? OFF_WCV : OFF_WCK)) + (size_t)layer * 128 * 2048;
    const int m0 = mt * 128;
    gemm_mainloop(A, 1024, Bt, 2048, 2048, m0, 0, smem);
    const float* bias = small + kv * 128 + layer * 64;
    if (!kv) {
      u16* dst = (u16*)(ws + OFF_KC);
      for (int u = tid; u < 1024; u += 256) {
        int r = u >> 3, c8 = u & 7, d0 = c8 * 8;
        float v[8];
#pragma unroll
        for (int e = 0; e < 8; ++e) v[e] = sC[r * 132 + d0 + e] + bias[d0 + e];
        int n = m0 + r, G = n >> 5, tk = n & 31, uu = (tk >> 2) & 1;
        size_t off = ((size_t)bg * 16 + G) * 2048 + (((d0 >> 5) * 2 + uu) * 64 + kfrag_lane(tk, (d0 >> 3) & 3)) * 8;
        *(uint4*)(dst + off) = pack8(v);
      }
    } else {
      u16* dst = (u16*)(ws + OFF_VC);
      for (int u = tid; u < 1024; u += 256) {
        int tg = u >> 6, d = u & 63;
        float v[8];
#pragma unroll
        for (int e = 0; e < 8; ++e) v[e] = sC[(tg * 8 + e) * 132 + d] + bias[d];
        int n = m0 + tg * 8, G = n >> 5, g4 = (n & 31) >> 3;
        size_t off = ((size_t)bg * 16 + G) * 2048 + ((d >> 4) * 64 + (d & 15) + 16 * g4) * 8;
        *(uint4*)(dst + off) = pack8(v);
      }
    }
    __syncthreads();
  }
}

DEV void diff_attn_item(const Params& p, int layer, int b, int h, int qt) {
  char* ws = p.ws;
  const int tid = otid(), lane = tid & 63, wid = tid >> 6;
  const int g4 = lane >> 4, col = lane & 15;
  const int q0 = qt * 128 + wid * 32;
  const float lam = ((const float*)(ws + OFF_SMALL))[256 + layer];
  const float lam_init = 0.8f - 0.6f * expf(-0.3f * layer);
  bf16x8 Qf[2][2];
  const u16* Kb[2];
#pragma unroll
  for (int m = 0; m < 2; ++m) {
    const u16* Qb = (const u16*)(ws + OFF_QA) + (size_t)(b * 12 + h * 2 + m) * T * 32;
#pragma unroll
    for (int cgi = 0; cgi < 2; ++cgi) Qf[m][cgi] = ldfrag(Qb + (size_t)(q0 + cgi * 16 + col) * 32 + g4 * 8);
    Kb[m] = (const u16*)(ws + OFF_KA) + (size_t)(b * 12 + h * 2 + m) * 256 * 1024 + lane * 8;
  }
  const u16* Vb = (const u16*)(ws + OFF_VA) + (size_t)(b * 6 + h) * 256 * 2048 + lane * 8;
  f32x4 O[2][2][4];
  float mr[2][2], lr[2][2];
#pragma unroll
  for (int m = 0; m < 2; ++m)
#pragma unroll
    for (int cgi = 0; cgi < 2; ++cgi) {
      mr[m][cgi] = -1e30f; lr[m][cgi] = 0.f;
#pragma unroll
      for (int dt = 0; dt < 4; ++dt) O[m][cgi][dt] = (f32x4){0.f, 0.f, 0.f, 0.f};
    }
  const int Gmax = qt * 4 + wid;
  for (int G = 0; G <= Gmax; ++G) {
    bf16x8 kf[2][2], vf[4];
#pragma unroll
    for (int m = 0; m < 2; ++m)
#pragma unroll
      for (int u = 0; u < 2; ++u) kf[m][u] = ldfrag(Kb[m] + (size_t)G * 1024 + u * 512);
#pragma unroll
    for (int dt = 0; dt < 4; ++dt) vf[dt] = ldfrag(Vb + (size_t)G * 2048 + dt * 512);
    const bool diag = (G == Gmax);
    const int kb = G * 32 + 8 * g4;
#pragma unroll
    for (int m = 0; m < 2; ++m)
#pragma unroll
      for (int cgi = 0; cgi < 2; ++cgi) {
        f32x4 z = {0.f, 0.f, 0.f, 0.f};
        f32x4 s0 = mfma16(kf[m][0], Qf[m][cgi], z);
        f32x4 s1 = mfma16(kf[m][1], Qf[m][cgi], z);
        float sv[8];
#pragma unroll
        for (int i = 0; i < 4; ++i) { sv[i] = s0[i]; sv[4 + i] = s1[i]; }
        if (diag) {
          const int qpos = q0 + cgi * 16 + col;
#pragma unroll
          for (int j = 0; j < 8; ++j) sv[j] = (kb + j <= qpos) ? sv[j] : -INFINITY;
        }
        float mx = fmaxf(fmaxf(fmaxf(sv[0], sv[1]), fmaxf(sv[2], sv[3])), fmaxf(fmaxf(sv[4], sv[5]), fmaxf(sv[6], sv[7])));
        mx = gmax4(mx);
        float mnew = fmaxf(mr[m][cgi], mx);
        float alpha = fexp2(mr[m][cgi] - mnew);
        mr[m][cgi] = mnew;
        float ps = 0.f;
#pragma unroll
        for (int j = 0; j < 8; ++j) { sv[j] = fexp2(sv[j] - mnew); ps += sv[j]; }
        lr[m][cgi] = lr[m][cgi] * alpha + ps;
        bf16x8 pb = as_frag(pack8(sv));
#pragma unroll
        for (int dt = 0; dt < 4; ++dt) {
          f32x4 o = O[m][cgi][dt];
          o[0] *= alpha; o[1] *= alpha; o[2] *= alpha; o[3] *= alpha;
          O[m][cgi][dt] = mfma16(vf[dt], pb, o);
        }
      }
  }
  const float* sg = p.subln + layer * 64;
  u16* mix = (u16*)(ws + OFF_MIX);
#pragma unroll
  for (int cgi = 0; cgi < 2; ++cgi) {
    float l0 = gsum4(lr[0][cgi]), l1 = gsum4(lr[1][cgi]);
    float i0 = 1.f / l0, i1 = lam / l1;
    float o[4][4];
    float ss = 0.f;
#pragma unroll
    for (int dt = 0; dt < 4; ++dt)
#pragma unroll
      for (int i = 0; i < 4; ++i) {
        float v = O[0][cgi][dt][i] * i0 - O[1][cgi][dt][i] * i1;
        o[dt][i] = v; ss += v * v;
      }
    ss = gsum4(ss);
    float rs = rsqrtf(ss * (1.f / 64.f) + 1e-6f) * (1.f - lam_init);
    const size_t row = (size_t)(b * T + q0 + cgi * 16 + col) * 1024 + h * 64;
#pragma unroll
    for (int dt = 0; dt < 4; ++dt) {
      int d = dt * 16 + 4 * g4;
      float4 gg = *(const float4*)(sg + d);
      uint2 w;
      w.x = pack2(o[dt][0] * rs * gg.x, o[dt][1] * rs * gg.y);
      w.y = pack2(o[dt][2] * rs * gg.z, o[dt][3] * rs * gg.w);
      *(uint2*)(mix + row + d) = w;
    }
  }
}

template <int MODE>
DEV void nsa_step(const u16* __restrict__ Kg, const u16* __restrict__ Vg, const bf16x8 (&Qf)[3][2], float (&mr)[3], float (&lr)[3],
                  f32x4 (&O)[3][4], int kb, int lo, int hi, float& e0, float& e1, float& ecar) {
  bf16x8 kf[2][2], vf[4];
#pragma unroll
  for (int ks = 0; ks < 2; ++ks)
#pragma unroll
    for (int u = 0; u < 2; ++u) kf[ks][u] = ldfrag(Kg + (ks * 2 + u) * 512);
  if (MODE != 0) {
#pragma unroll
    for (int dt = 0; dt < 4; ++dt) vf[dt] = ldfrag(Vg + dt * 512);
  }
#pragma unroll
  for (int h = 0; h < 3; ++h) {
    f32x4 z = {0.f, 0.f, 0.f, 0.f};
    f32x4 s0 = mfma16(kf[0][0], Qf[h][0], z);
    s0 = mfma16(kf[1][0], Qf[h][1], s0);
    f32x4 s1 = mfma16(kf[0][1], Qf[h][0], z);
    s1 = mfma16(kf[1][1], Qf[h][1], s1);
    float sv[8];
#pragma unroll
    for (int i = 0; i < 4; ++i) { sv[i] = s0[i]; sv[4 + i] = s1[i]; }
    if (MODE == 1) {
      const float m = mr[h], il = lr[h];
#pragma unroll
      for (int j = 0; j < 8; ++j) sv[j] = ((kb + j >= lo) && (kb + j <= hi)) ? fexp2(sv[j] - m) * il : 0.f;
      e0 += (sv[0] + sv[1]) + (sv[2] + sv[3]);
      e1 += (sv[4] + sv[5]) + (sv[6] + sv[7]) + sv[3];
      ecar += sv[7];
    } else {
#pragma unroll
      for (int j = 0; j < 8; ++j) sv[j] = ((kb + j >= lo) && (kb + j <= hi)) ? sv[j] : -INFINITY;
      float mx = fmaxf(fmaxf(fmaxf(sv[0], sv[1]), fmaxf(sv[2], sv[3])), fmaxf(fmaxf(sv[4], sv[5]), fmaxf(sv[6], sv[7])));
      mx = gmax4(mx);
      float mnew = fmaxf(mr[h], mx);
      float alpha = fexp2(mr[h] - mnew);
      mr[h] = mnew;
      float ps = 0.f;
#pragma unroll
      for (int j = 0; j < 8; ++j) { sv[j] = fexp2(sv[j] - mnew); ps += sv[j]; }
      lr[h] = lr[h] * alpha + ps;
      if (MODE == 2) {
#pragma unroll
        for (int dt = 0; dt < 4; ++dt) {
          O[h][dt][0] *= alpha; O[h][dt][1] *= alpha; O[h][dt][2] *= alpha; O[h][dt][3] *= alpha;
        }
      }
    }
    if (MODE != 0) {
      bf16x8 pb = as_frag(pack8(sv));
#pragma unroll
      for (int dt = 0; dt < 4; ++dt) O[h][dt] = mfma16(vf[dt], pb, O[h][dt]);
    }
  }
}

DEV void nsa_item(const Params& p, int layer, int b, int g, int c, char* smem) {
  char* ws = p.ws;
  const int tid = otid(), lane = tid & 63, wid = tid >> 6;
  const int g4 = lane >> 4, col = lane & 15;
  const int t0 = c * 64 + wid * 16;
  const int t = t0 + col;
  const int bg = b * 2 + g;
  float* impA = (float*)(smem + wid * 12672);
  float* impC = impA + 2048;
  unsigned* selm = (unsigned*)(impC + 1056);
  bf16x8 Qf[3][2];
#pragma unroll
  for (int h = 0; h < 3; ++h)
#pragma unroll
    for (int ks = 0; ks < 2; ++ks)
      Qf[h][ks] = ldfrag((const u16*)(ws + OFF_QC) + ((size_t)(b * 6 + g * 3 + h) * T + t) * 64 + ks * 32 + g4 * 8);
  const float* gates = (const float*)(ws + OFF_GATES) + (size_t)(b * T + t) * 18 + g * 9;
  f32x4 O[3][4];
  uint2 OUT[3][4];
  float mr[3], lr[3];
  float e0 = 0.f, e1 = 0.f, ecar = 0.f;
  const u16* KC = (const u16*)(ws + OFF_KC) + (size_t)bg * 16 * 2048 + lane * 8;
  const u16* VC = (const u16*)(ws + OFF_VC) + (size_t)bg * 16 * 2048 + lane * 8;
  const int Gc = (4 * c + 2) >> 5;
  const int hic = (t - 31) >> 4;
#pragma unroll
  for (int h = 0; h < 3; ++h) { mr[h] = -1e30f; lr[h] = 0.f; }
  for (int G = 0; G <= Gc; ++G)
    nsa_step<0>(KC + G * 2048, VC + G * 2048, Qf, mr, lr, O, G * 32 + 8 * g4, 0, hic, e0, e1, ecar);
#pragma unroll
  for (int h = 0; h < 3; ++h) {
    float l = gsum4(lr[h]);
    lr[h] = (l > 0.f) ? 1.f / l : 0.f;
#pragma unroll
    for (int dt = 0; dt < 4; ++dt) O[h][dt] = (f32x4){0.f, 0.f, 0.f, 0.f};
  }
  for (int G = 0; G <= Gc; ++G) {
    e0 = 0.f; e1 = 0.f; ecar = 0.f;
    nsa_step<1>(KC + G * 2048, VC + G * 2048, Qf, mr, lr, O, G * 32 + 8 * g4, 0, hic, e0, e1, ecar);
    const int s0 = 8 * G + 2 * g4;
    impA[col * 128 + s0] = e0;
    impA[col * 128 + s0 + 1] = e1;
    impC[col * 65 + (s0 >> 1) + 1] = ecar;
  }
#pragma unroll
  for (int h = 0; h < 3; ++h) {
    const float gt = gates[h * 3 + 0];
#pragma unroll
    for (int dt = 0; dt < 4; ++dt) {
      OUT[h][dt].x = pack2(O[h][dt][0] * gt, O[h][dt][1] * gt);
      OUT[h][dt].y = pack2(O[h][dt][2] * gt, O[h][dt][3] * gt);
    }
  }
  __syncthreads();
  {
    const int nsel = (c + 1 < 16) ? (c + 1) : 16;
    for (int qb = 0; qb < 4; ++qb) {
      const int q = qb * 4 + g4;
      int key[8];
#pragma unroll
      for (int k = 0; k < 8; ++k) {
        const int blk = col + 16 * k;
        float v = impA[q * 128 + blk];
        if ((blk & 1) == 0 && blk >= 2) v += impC[q * 65 + (blk >> 1)];
        int kk;
        if (blk > c) kk = 0;
        else if (blk == 0 || blk == c || blk + 1 == c) kk = 0x7F000000 + (127 - blk);
        else kk = (int)(((__float_as_uint(v) & ~127u) | (unsigned)(127 - blk)) + 128u);
        key[k] = kk;
      }
      unsigned mw0 = 0, mw1 = 0, mw2 = 0, mw3 = 0;
      for (int r = 0; r < nsel; ++r) {
        int best = max(max(max(key[0], key[1]), max(key[2], key[3])), max(max(key[4], key[5]), max(key[6], key[7])));
        best = rowmax_i(best);
        const int blk = 127 - (best & 127);
        const unsigned bit = 1u << (blk & 31);
        const int wsel = blk >> 5;
        mw0 |= (wsel == 0) ? bit : 0u; mw1 |= (wsel == 1) ? bit : 0u;
        mw2 |= (wsel == 2) ? bit : 0u; mw3 |= (wsel == 3) ? bit : 0u;
#pragma unroll
        for (int k = 0; k < 8; ++k) key[k] = (key[k] == best) ? 0 : key[k];
      }
      if (col == 0) { selm[q * 4 + 0] = mw0; selm[q * 4 + 1] = mw1; selm[q * 4 + 2] = mw2; selm[q * 4 + 3] = mw3; }
    }
  }
  __syncthreads();
  const unsigned sw0 = selm[col * 4 + 0], sw1 = selm[col * 4 + 1], sw2 = selm[col * 4 + 2], sw3 = selm[col * 4 + 3];
#pragma unroll
  for (int h = 0; h < 3; ++h) {
    mr[h] = -1e30f; lr[h] = 0.f;
#pragma unroll
    for (int dt = 0; dt < 4; ++dt) O[h][dt] = (f32x4){0.f, 0.f, 0.f, 0.f};
  }
  {
    const u16* KS = (const u16*)(ws + OFF_KSL) + (size_t)bg * 256 * 2048 + lane * 8;
    const u16* VS = (const u16*)(ws + OFF_VSL) + (size_t)bg * 256 * 2048 + lane * 8;
    for (int s = 0; s <= c; ++s) {
      const int wsel = s >> 5;
      const unsigned word = (wsel == 0) ? sw0 : (wsel == 1) ? sw1 : (wsel == 2) ? sw2 : sw3;
      const bool sel = (word >> (s & 31)) & 1u;
      if (__ballot(sel) == 0ull) continue;
      const int hi = sel ? t : -1;
#pragma unroll 1
      for (int hf = 0; hf < 2; ++hf) {
        const int G = 2 * s + hf;
        nsa_step<2>(KS + (size_t)G * 2048, VS + (size_t)G * 2048, Qf, mr, lr, O, G * 32 + 8 * g4, 0, hi, e0, e1, ecar);
      }
    }
  }
#pragma unroll
  for (int h = 0; h < 3; ++h) {
    const float l = gsum4(lr[h]);
    const float gt = gates[h * 3 + 1] * ((l > 0.f) ? 1.f / l : 0.f);
#pragma unroll
    for (int dt = 0; dt < 4; ++dt) {
      OUT[h][dt].x = pack2(bflo(OUT[h][dt].x) + O[h][dt][0] * gt, bfhi(OUT[h][dt].x) + O[h][dt][1] * gt);
      OUT[h][dt].y = pack2(bflo(OUT[h][dt].y) + O[h][dt][2] * gt, bfhi(OUT[h][dt].y) + O[h][dt][3] * gt);
      O[h][dt] = (f32x4){0.f, 0.f, 0.f, 0.f};
    }
    mr[h] = -1e30f; lr[h] = 0.f;
  }
  {
    const u16* KW = (const u16*)(ws + OFF_KWI) + (size_t)bg * 256 * 2048 + lane * 8;
    const u16* VW = (const u16*)(ws + OFF_VWI) + (size_t)bg * 256 * 2048 + lane * 8;
    const int Glo = (t0 - 511 > 0) ? ((t0 - 511) >> 5) : 0;
    const int Ghi = (t0 + 15) >> 5;
    for (int G = Glo; G <= Ghi; ++G)
      nsa_step<2>(KW + (size_t)G * 2048, VW + (size_t)G * 2048, Qf, mr, lr, O, G * 32 + 8 * g4, t - 511, t, e0, e1, ecar);
  }
  u16* mix = (u16*)(ws + OFF_MIX);
  const size_t row = (size_t)(b * T + t) * 1024 + 640 + g * 192;
#pragma unroll
  for (int h = 0; h < 3; ++h) {
    const float l = gsum4(lr[h]);
    const float gt = gates[h * 3 + 2] * ((l > 0.f) ? 1.f / l : 0.f);
#pragma unroll
    for (int dt = 0; dt < 4; ++dt) {
      float a0 = bflo(OUT[h][dt].x) + O[h][dt][0] * gt, a1 = bfhi(OUT[h][dt].x) + O[h][dt][1] * gt;
      float a2 = bflo(OUT[h][dt].y) + O[h][dt][2] * gt, a3 = bfhi(OUT[h][dt].y) + O[h][dt][3] * gt;
      uint2 w; w.x = pack2(a0, a1); w.y = pack2(a2, a3);
      *(uint2*)(mix + row + h * 64 + dt * 16 + 4 * g4) = w;
    }
  }
  __syncthreads();
}

DEV void pool_item(const Params& p, int layer, int item, char* smem) {
  char* ws = p.ws;
  const int tid = otid();
  const int m0 = item * 64, t0 = m0 & (T - 1);
  float* uS = (float*)smem;
  float* yS = uS + 79 * 64;
  const u16* U = (const u16*)(ws + OFF_U);
  u16* mix = (u16*)(ws + OFF_MIX);
  for (int gi = 0; gi < 4; ++gi) {
    const int w = 2 << gi;
#pragma unroll 2
    for (int i = tid; i < 79 * 64; i += 256) {
      int r = i >> 6, cc = i & 63;
      int tt = t0 - 15 + r;
      uS[i] = (tt >= 0) ? bf2f(U[(size_t)(m0 - 15 + r) * 256 + gi * 64 + cc]) : 0.f;
    }
    __syncthreads();
    {
      const int cc = tid & 63, tq = tid >> 6;
#pragma unroll 1
      for (int j = 0; j < 16; ++j) {
        int tl = tq * 16 + j;
        int tt = t0 + tl;
        int cnt = (tt + 1 < w) ? (tt + 1) : w;
        float s = 0.f;
        for (int k = 0; k < cnt; ++k) s += uS[(tl + 15 - k) * 64 + cc];
        yS[tl * 65 + cc] = s / (float)cnt - uS[(tl + 15) * 64 + cc];
      }
    }
    __syncthreads();
    {
      const int dc = tid & 63, tq = tid >> 6;
      const float* W = p.w_pool + (size_t)layer * 4 * 4096 + (size_t)gi * 4096;
      float acc[16];
#pragma unroll
      for (int j = 0; j < 16; ++j) acc[j] = 0.f;
#pragma unroll 2
      for (int cc = 0; cc < 64; ++cc) {
        float wv = W[cc * 64 + dc];
#pragma unroll
        for (int j = 0; j < 16; ++j) acc[j] += yS[(tq * 16 + j) * 65 + cc] * wv;
      }
      const float sc = p.pool_scale[layer * 256 + gi * 64 + dc];
#pragma unroll
      for (int j = 0; j < 16; ++j) {
        unsigned pk = pack2(acc[j] * sc, 0.f);
        mix[(size_t)(m0 + tq * 16 + j) * 1024 + 384 + gi * 64 + dc] = (u16)(pk & 0xFFFFu);
      }
    }
    __syncthreads();
  }
}

DEV int next_item(int* ctr, int* s_item) {
  if (otid() == 0) *s_item = atomicAdd(ctr, 1);
  __syncthreads();
  const int k = *s_item;
  __syncthreads();
  return k;
}
DEV void phase_mixers(const Params& p, int layer, char* smem, int* s_item) {
  int* ctr = (int*)(p.ws + OFF_SMALL) + 260 + layer * 3;
  while (true) {
    const int k = next_item(ctr + 0, s_item);
    if (k >= 1536) break;
    const int r = k % 24;
    diff_attn_item(p, layer, r / 6, r % 6, 63 - k / 24);
  }
  while (true) {
    const int k = next_item(ctr + 1, s_item);
    if (k >= 1024) break;
    nsa_item(p, layer, (k & 7) >> 1, k & 1, 127 - (k >> 3), smem);
  }
  while (true) {
    const int k = next_item(ctr + 2, s_item);
    if (k >= 512) break;
    pool_item(p, layer, k, smem);
  }
}

DEV void phase_gemm(const Params& p, int layer, int kind, char* smem) {
  char* ws = p.ws;
  const int tid = otid();
  const float* sC = (const float*)smem;
  const u16* A; const u16* Bt; int K, NT;
  if (kind == 0) { A = (const u16*)(ws + OFF_MIX); Bt = (const u16*)(ws + OFF_WOUT) + (size_t)layer * 1024 * 1024; K = 1024; NT = 8; }
  else if (kind == 1) { A = (const u16*)(ws + OFF_XB); Bt = (const u16*)(ws + OFF_WUP) + (size_t)layer * 4096 * 1024; K = 1024; NT = 32; }
  else { A = (const u16*)(ws + OFF_H); Bt = (const u16*)(ws + OFF_WDOWN) + (size_t)layer * 4096 * 1024; K = 4096; NT = 8; }
  const int ntiles = (MTOK / 128) * NT;
  for (int tile = blockIdx.x; tile < ntiles; tile += gridDim.x) {
    const int tn = tile % NT, tm = tile / NT;
    const int m0 = tm * 128, n0 = tn * 128;
    gemm_mainloop(A, K, Bt, K, K, m0, n0, smem);
    if (kind == 1) {
      u16* H = (u16*)(ws + OFF_H);
      for (int u = tid; u < 2048; u += 256) {
        int r = u >> 4, c8 = u & 15;
        float v[8];
#pragma unroll
        for (int e = 0; e < 8; ++e) { float a = fmaxf(sC[r * 132 + c8 * 8 + e], 0.f); v[e] = a * a; }
        *(uint4*)(H + (size_t)(m0 + r) * 4096 + n0 + c8 * 8) = pack8(v);
      }
    } else {
      const bool resf32 = (kind == 0 && layer == 0);
      const u16* xb = (const u16*)(ws + OFF_XB);
      for (int u = tid; u < 4096; u += 256) {
        int r = u >> 5, c4 = u & 31;
        float4 v = *(const float4*)(sC + r * 132 + c4 * 4);
        size_t idx = (size_t)(m0 + r) * 1024 + n0 + c4 * 4;
        float4 rs;
        if (resf32) rs = *(const float4*)(p.x + idx);
        else { uint2 w = *(const uint2*)(xb + idx); rs.x = bflo(w.x); rs.y = bfhi(w.x); rs.z = bflo(w.y); rs.w = bfhi(w.y); }
        float4 o; o.x = ALPHA * rs.x + v.x; o.y = ALPHA * rs.y + v.y; o.z = ALPHA * rs.z + v.z; o.w = ALPHA * rs.w + v.w;
        *(float4*)(p.out + idx) = o;
      }
    }
    __syncthreads();
  }
}

DEV void phase_ln(const Params& p, const float* g, const float* bta, bool final_) {
  const int lane = otid() & 63, wid = otid() >> 6;
  u16* xb = (u16*)(p.ws + OFF_XB);
  for (int row = blockIdx.x * 4 + wid; row < MTOK; row += gridDim.x * 4) {
    float* y = p.out + (size_t)row * 1024;
    float4 v[4];
    float s = 0.f;
#pragma unroll
    for (int j = 0; j < 4; ++j) { v[j] = *(const float4*)(y + (j * 64 + lane) * 4); s += (v[j].x + v[j].y) + (v[j].z + v[j].w); }
    const float mu = wsum(s) * (1.f / 1024.f);
    float q = 0.f;
#pragma unroll
    for (int j = 0; j < 4; ++j) {
      float a = v[j].x - mu, b = v[j].y - mu, c = v[j].z - mu, d = v[j].w - mu;
      q += (a * a + b * b) + (c * c + d * d);
    }
    const float rstd = rsqrtf(wsum(q) * (1.f / 1024.f) + 1e-5f);
#pragma unroll
    for (int j = 0; j < 4; ++j) {
      const int cidx = (j * 64 + lane) * 4;
      float4 gg = *(const float4*)(g + cidx), bb = *(const float4*)(bta + cidx);
      float4 o;
      o.x = (v[j].x - mu) * rstd * gg.x + bb.x; o.y = (v[j].y - mu) * rstd * gg.y + bb.y;
      o.z = (v[j].z - mu) * rstd * gg.z + bb.z; o.w = (v[j].w - mu) * rstd * gg.w + bb.w;
      if (final_) *(float4*)(y + cidx) = o;
      else { uint2 w; w.x = pack2(o.x, o.y); w.y = pack2(o.z, o.w); *(uint2*)(xb + (size_t)row * 1024 + cidx) = w; }
    }
  }
}

__global__ void __launch_bounds__(256, 2) hymba_mega(Params p) {
  __shared__ __attribute__((aligned(16))) char smem[SMEM_BYTES];
  __shared__ int s_item;
  for (int ph = p.pbeg; ph < p.pend; ++ph) {
    if (ph == 0) phase_prep(p, smem);
    else {
      const int layer = (ph - 1) >> 3, sub = (ph - 1) & 7;
      switch (sub) {
        case 0: phase_inproj(p, layer, smem); break;
        case 1: phase_compress(p, layer, smem); break;
        case 2: phase_mixers(p, layer, smem, &s_item); break;
        case 3: phase_gemm(p, layer, 0, smem); break;
        case 4: phase_ln(p, p.ln1g + layer * 1024, p.ln1b + layer * 1024, false); break;
        case 5: phase_gemm(p, layer, 1, smem); break;
        case 6: phase_gemm(p, layer, 2, smem); break;
        default: phase_ln(p, p.ln2g + layer * 1024, p.ln2b + layer * 1024, layer == 1); break;
      }
    }
    if (p.coop && ph + 1 < p.pend) cg::this_grid().sync();
  }
}

extern "C" void kernel_launch(void* const* d_in, const int* in_sizes, int n_in, void* d_out, int out_size, void* d_ws,
                              size_t ws_size, hipStream_t stream) {
  static int grid_blocks = 0;
  if (!grid_blocks) {
    int dev = 0, cus = 0, per_cu = 0;
    hipGetDevice(&dev);
    hipDeviceGetAttribute(&cus, hipDeviceAttributeMultiprocessorCount, dev);
    hipOccupancyMaxActiveBlocksPerMultiprocessor(&per_cu, hymba_mega, 256, 0);
    if (per_cu < 1) per_cu = 1;
    if (per_cu > 2) per_cu = 2;
    grid_blocks = cus * per_cu;
  }
  Params p{};
  const float* const* in = (const float* const*)d_in;
  p.x = in[0]; p.w_in = in[1]; p.lq1 = in[2]; p.lk1 = in[3]; p.lq2 = in[4]; p.lk2 = in[5]; p.subln = in[6];
  p.w_pool = in[7]; p.pool_scale = in[8]; p.pe_k = in[9]; p.pe_v = in[10]; p.w_ck = in[11]; p.w_cv = in[12];
  p.w_out = in[13]; p.ln1g = in[14]; p.ln1b = in[15]; p.w_up = in[16]; p.w_down = in[17]; p.ln2g = in[18]; p.ln2b = in[19];
  p.out = (float*)d_out;
  p.ws = (char*)d_ws;
  p.pad = 0;
  const int NPH = 17;
#if COOP
  p.pbeg = 0; p.pend = NPH; p.coop = 1;
  void* args[] = {&p};
  hipError_t e = hipLaunchCooperativeKernel((void*)hymba_mega, dim3(grid_blocks), dim3(256), args, 0, stream);
  if (e != hipSuccess) fprintf(stderr, "cooperative launch failed: %s (grid %d)\n", hipGetErrorString(e), grid_blocks);
#else
  for (int ph = 0; ph < NPH; ++ph) {
    p.pbeg = ph; p.pend = ph + 1; p.coop = 0;
    hipLaunchKernelGGL(hymba_mega, dim3(grid_blocks), dim3(256), 0, stream, p);
  }
#endif
}
```

```cpp
#include <hip/hip_runtime.h>
#include <hip/hip_cooperative_groups.h>
#include <math.h>
#include <cstdio>
namespace cg = cooperative_groups;

typedef unsigned short u16;
typedef __attribute__((ext_vector_type(8))) short bf16x8;
typedef __attribute__((ext_vector_type(4))) float f32x4;
typedef __attribute__((ext_vector_type(16))) float f32x16;
typedef __attribute__((ext_vector_type(4))) unsigned u32x4;

#define DEV __device__ __forceinline__
#ifndef COOP
#define COOP 1
#endif

constexpr int NB = 4, T = 8192, DM = 1024, MTOK = NB * T, NIN = 2578, NINP = 2688, DFF = 4096;
constexpr float ALPHA = 1.4142135623730951f;
constexpr float LOG2E = 1.4426950408889634f;
constexpr int SMEM_BYTES = 73728;
constexpr float RESCALE_THR = 6.0f;

constexpr size_t OFF_WIN = 0;
constexpr size_t OFF_WOUT = OFF_WIN + (size_t)2 * NINP * 1024 * 2;
constexpr size_t OFF_WUP = OFF_WOUT + (size_t)2 * 1024 * 1024 * 2;
constexpr size_t OFF_WDOWN = OFF_WUP + (size_t)2 * 4096 * 1024 * 2;
constexpr size_t OFF_WCK = OFF_WDOWN + (size_t)2 * 4096 * 1024 * 2;
constexpr size_t OFF_WCV = OFF_WCK + (size_t)2 * 128 * 2048 * 2;
constexpr size_t OFF_SMALL = OFF_WCV + (size_t)2 * 128 * 2048 * 2;
constexpr size_t OFF_ROPEA = OFF_SMALL + 4096;
constexpr size_t OFF_ROPEC = OFF_ROPEA + (size_t)2 * T * 16 * 4;
constexpr size_t OFF_XB = OFF_ROPEC + (size_t)2 * T * 32 * 4;
constexpr size_t OFF_R = OFF_XB + (size_t)MTOK * 1024 * 2;
constexpr size_t OFF_QA = OFF_R;
constexpr size_t OFF_KA = OFF_QA + (size_t)NB * 12 * T * 32 * 2;
constexpr size_t OFF_VA = OFF_KA + (size_t)NB * 12 * T * 32 * 2;
constexpr size_t OFF_U = OFF_VA + (size_t)NB * 6 * T * 64 * 2;
constexpr size_t OFF_QC = OFF_U + (size_t)MTOK * 256 * 2;
constexpr size_t KVSZ = (size_t)NB * 2 * T * 64 * 2;
constexpr size_t OFF_KCM = OFF_QC + (size_t)NB * 6 * T * 64 * 2;
constexpr size_t OFF_VCM = OFF_KCM + KVSZ;
constexpr size_t OFF_KSL = OFF_VCM + KVSZ;
constexpr size_t OFF_VSL = OFF_KSL + KVSZ;
constexpr size_t OFF_KWI = OFF_VSL + KVSZ;
constexpr size_t OFF_VWI = OFF_KWI + KVSZ;
constexpr size_t OFF_GATES = OFF_VWI + KVSZ;
constexpr size_t OFF_KC = OFF_GATES + (size_t)MTOK * 18 * 4;
constexpr size_t OFF_VC = OFF_KC + (size_t)NB * 2 * 512 * 64 * 2;
constexpr size_t OFF_MIX = OFF_VC + (size_t)NB * 2 * 512 * 64 * 2;
constexpr size_t OFF_MIX_END = OFF_MIX + (size_t)MTOK * 1024 * 2;
constexpr size_t OFF_H = OFF_R;
constexpr size_t OFF_END = OFF_R + (size_t)MTOK * 4096 * 2;
static_assert(OFF_MIX_END <= OFF_END, "mixer buffers must fit in H region");
constexpr size_t OFF_XBAR = OFF_END;
constexpr int XCD_BAR_WORDS = 3456;
constexpr size_t OFF_YB = OFF_XBAR + 16384;

struct Params {
  const float *x, *w_in, *lq1, *lk1, *lq2, *lk2, *subln, *w_pool, *pool_scale, *pe_k, *pe_v, *w_ck, *w_cv,
      *w_out, *ln1g, *ln1b, *w_up, *w_down, *ln2g, *ln2b;
  float* out;
  char* ws;
  int pbeg, pend, coop, pad;
};

DEV int otid() { int t = threadIdx.x; asm volatile("" : "+v"(t)); return t; }
DEV unsigned pack2(float a, float b) {
  unsigned r;
  asm("v_cvt_pk_bf16_f32 %0, %1, %2" : "=v"(r) : "v"(a), "v"(b));
  return r;
}
DEV float bf2f(u16 h) { return __uint_as_float(((unsigned)h) << 16); }
DEV float bflo(unsigned w) { return __uint_as_float(w << 16); }
DEV float bfhi(unsigned w) { return __uint_as_float(w & 0xFFFF0000u); }
DEV float fexp2(float x) { return __builtin_amdgcn_exp2f(x); }
DEV uint4 pack8(const float* v) {
  uint4 r;
  r.x = pack2(v[0], v[1]); r.y = pack2(v[2], v[3]); r.z = pack2(v[4], v[5]); r.w = pack2(v[6], v[7]);
  return r;
}
DEV bf16x8 as_frag(uint4 v) {
  union { uint4 u; bf16x8 f; } c; c.u = v; return c.f;
}
DEV bf16x8 ldfrag(const u16* p) { return as_frag(*(const uint4*)p); }
DEV f32x4 mfma16(bf16x8 a, bf16x8 b, f32x4 c) { return __builtin_amdgcn_mfma_f32_16x16x32_bf16(a, b, c, 0, 0, 0); }
DEV float max3(float a, float b, float c) {
  float r;
  asm("v_max3_f32 %0, %1, %2, %3" : "=v"(r) : "v"(a), "v"(b), "v"(c));
  return r;
}
DEV float max8(const float* s) { return max3(max3(s[0], s[1], s[2]), max3(s[3], s[4], s[5]), max3(s[6], s[7], s[7])); }
DEV bf16x8 ones_frag() {
  bf16x8 o;
#pragma unroll
  for (int i = 0; i < 8; ++i) o[i] = (short)0x3F80;
  return o;
}
DEV bf16x8 pack8_frag(const float* v) {
  unsigned r0, r1, r2, r3;
  asm("v_cvt_pk_bf16_f32 %0, %4, %5\n\tv_cvt_pk_bf16_f32 %1, %6, %7\n\tv_cvt_pk_bf16_f32 %2, %8, %9\n\tv_cvt_pk_bf16_f32 %3, %10, %11\n\ts_nop 4"
      : "=&v"(r0), "=&v"(r1), "=&v"(r2), "=&v"(r3)
      : "v"(v[0]), "v"(v[1]), "v"(v[2]), "v"(v[3]), "v"(v[4]), "v"(v[5]), "v"(v[6]), "v"(v[7]));
  uint4 u; u.x = r0; u.y = r1; u.z = r2; u.w = r3;
  return as_frag(u);
}
DEV float wsum(float v) {
#pragma unroll
  for (int o = 32; o >= 1; o >>= 1) v += __shfl_xor(v, o);
  return v;
}
DEV float gmax4(float v) {
  v = fmaxf(v, __shfl_xor(v, 16));
  v = fmaxf(v, __shfl_xor(v, 32));
  return v;
}
DEV float gsum4(float v) {
  v += __shfl_xor(v, 16);
  v += __shfl_xor(v, 32);
  return v;
}
DEV int rowmax_i(int v) {
  int t;
  t = __builtin_amdgcn_update_dpp(0, v, 0xB1, 0xF, 0xF, true); v = max(v, t);
  t = __builtin_amdgcn_update_dpp(0, v, 0x4E, 0xF, 0xF, true); v = max(v, t);
  t = __builtin_amdgcn_update_dpp(0, v, 0x141, 0xF, 0xF, true); v = max(v, t);
  t = __builtin_amdgcn_update_dpp(0, v, 0x140, 0xF, 0xF, true); v = max(v, t);
  return v;
}

DEV void gemm_mainloop(const u16* __restrict__ A, int lda, const u16* __restrict__ Bt, int ldb, int K, int m0, int n0,
                       char* smem) {
  const int tid = otid(), lane = tid & 63, wid = tid >> 6;
  const int wm = wid >> 1, wn = wid & 1;
  const int lr = tid >> 3, lc = tid & 7;
  const u16* ga = A + (size_t)(m0 + lr) * lda + lc * 8;
  const u16* gb = Bt + (size_t)(n0 + lr) * ldb + lc * 8;
  const size_t sa32 = (size_t)32 * lda, sb32 = (size_t)32 * ldb;
  const int nk = K >> 6;
  f32x16 acc[2][2];
#pragma unroll
  for (int i = 0; i < 2; ++i)
#pragma unroll
    for (int j = 0; j < 2; ++j)
#pragma unroll
      for (int r = 0; r < 16; ++r) acc[i][j][r] = 0.f;
  u32x4 a0[4], b0[4], a1[4], b1[4];
#define GEMM_ISSUE(RA, RB, KT)                                                              \
  {                                                                                         \
    const int kn_ = ((KT) < nk) ? (KT) : (nk - 1);                                          \
    _Pragma("unroll") for (int i = 0; i < 4; ++i) {                                         \
      const u16* pa_ = ga + i * sa32 + kn_ * 64;                                            \
      const u16* pb_ = gb + i * sb32 + kn_ * 64;                                            \
      asm volatile("global_load_dwordx4 %0, %1, off" : "=v"(RA[i]) : "v"(pa_));             \
      asm volatile("global_load_dwordx4 %0, %1, off" : "=v"(RB[i]) : "v"(pb_));             \
    }                                                                                       \
  }
#define GEMM_STORE(RA, RB, STAGE)                                                           \
  {                                                                                         \
    char* dA_ = smem + (STAGE) * 36864;                                                     \
    char* dB_ = dA_ + 18432;                                                                \
    _Pragma("unroll") for (int i = 0; i < 4; ++i) {                                         \
      *(u32x4*)(dA_ + (lr + 32 * i) * 144 + lc * 16) = RA[i];                               \
      *(u32x4*)(dB_ + (lr + 32 * i) * 144 + lc * 16) = RB[i];                               \
    }                                                                                       \
  }
#define GEMM_COMPUTE(STAGE)                                                                 \
  {                                                                                         \
    const char* sA_ = smem + (STAGE) * 36864;                                               \
    const char* sB_ = sA_ + 18432;                                                          \
    _Pragma("unroll") for (int ks = 0; ks < 4; ++ks) {                                      \
      bf16x8 af[2], bfr[2];                                                                 \
      _Pragma("unroll") for (int i = 0; i < 2; ++i)                                         \
        af[i] = as_frag(*(const uint4*)(sA_ + (wm * 64 + i * 32 + frow) * 144 + ks * 32 + fk)); \
      _Pragma("unroll") for (int j = 0; j < 2; ++j)                                         \
        bfr[j] = as_frag(*(const uint4*)(sB_ + (wn * 64 + j * 32 + frow) * 144 + ks * 32 + fk)); \
      _Pragma("unroll") for (int i = 0; i < 2; ++i)                                         \
        _Pragma("unroll") for (int j = 0; j < 2; ++j)                                       \
          acc[i][j] = __builtin_amdgcn_mfma_f32_32x32x16_bf16(af[i], bfr[j], acc[i][j], 0, 0, 0); \
    }                                                                                       \
  }
  const int frow = lane & 31, fk = (lane >> 5) * 16;
  GEMM_ISSUE(a0, b0, 0);
  GEMM_ISSUE(a1, b1, 1);
  asm volatile("s_waitcnt vmcnt(8)" ::: "memory");
  GEMM_STORE(a0, b0, 0);
  __syncthreads();
  for (int kt = 0; kt + 2 < nk; kt += 2) {
    GEMM_ISSUE(a0, b0, kt + 2);
    GEMM_COMPUTE(0);
    asm volatile("s_waitcnt vmcnt(8)" ::: "memory");
    GEMM_STORE(a1, b1, 1);
    __syncthreads();
    GEMM_ISSUE(a1, b1, kt + 3);
    GEMM_COMPUTE(1);
    asm volatile("s_waitcnt vmcnt(8)" ::: "memory");
    GEMM_STORE(a0, b0, 0);
    __syncthreads();
  }
  GEMM_COMPUTE(0);
  asm volatile("s_waitcnt vmcnt(0)" ::: "memory");
  GEMM_STORE(a1, b1, 1);
  __syncthreads();
  GEMM_COMPUTE(1);
  __syncthreads();
#undef GEMM_ISSUE
#undef GEMM_STORE
#undef GEMM_COMPUTE
  float* sC = (float*)smem;
#pragma unroll
  for (int i = 0; i < 2; ++i)
#pragma unroll
    for (int j = 0; j < 2; ++j)
#pragma unroll
      for (int r = 0; r < 16; ++r) {
        int row = wm * 64 + i * 32 + (r & 3) + 8 * (r >> 2) + 4 * (lane >> 5);
        int col = wn * 64 + j * 32 + (lane & 31);
        sC[row * 132 + col] = acc[i][j][r];
      }
  __syncthreads();
}

DEV bool next_tile(int it, int ntiles, int MT, int NG, int& tm, int& tn) {
  int idx;
  if ((gridDim.x & 7) == 0) {
    const int nlb = gridDim.x >> 3;
    idx = (it * 8 + (blockIdx.x & 7)) * nlb + (blockIdx.x >> 3);
  } else idx = it * gridDim.x + blockIdx.x;
  if (idx >= ntiles) return false;
  const int per = MT * NG;
  const int cgp = idx / per, rem = idx - cgp * per;
  tm = rem / NG; tn = cgp * NG + (rem - tm * NG);
  return true;
}

DEV int kfrag_lane(int tk, int g4) { return ((tk >> 3) << 2) + (tk & 3) + 16 * g4; }

DEV void transpose_tile(const float* __restrict__ src, u16* __restrict__ dst, int K, int N, int tn, int tile, char* smem) {
  float* tl = (float*)smem;
  const int tid = otid();
  const int k0 = (tile / tn) << 6, n0 = (tile % tn) << 6;
  float tmp[16];
#pragma unroll
  for (int i = 0; i < 16; ++i) {
    int r = (tid >> 6) + 4 * i, c = tid & 63, n = n0 + c;
    tmp[i] = (n < N) ? src[(size_t)(k0 + r) * N + n] : 0.f;
  }
#pragma unroll
  for (int i = 0; i < 16; ++i) tl[((tid >> 6) + 4 * i) * 65 + (tid & 63)] = tmp[i];
  __syncthreads();
#pragma unroll
  for (int j = 0; j < 2; ++j) {
    int ch = tid + 256 * j, n = ch >> 3, kc = ch & 7;
    float v[8];
#pragma unroll
    for (int e = 0; e < 8; ++e) v[e] = tl[(kc * 8 + e) * 65 + n];
    *(uint4*)(dst + (size_t)(n0 + n) * K + k0 + kc * 8) = pack8(v);
  }
  __syncthreads();
}

DEV void sincos_d(double x, double& s, double& c) {
  const double TWO_OVER_PI = 0.63661977236758134308;
  const double PIO2_HI = 1.57079632679489655800e+00, PIO2_LO = 6.12323399573676603587e-17;
  double kd = rint(x * TWO_OVER_PI);
  double r = (x - kd * PIO2_HI) - kd * PIO2_LO;
  double r2 = r * r;
  double sp = r * (1.0 + r2 * (-1.0 / 6 + r2 * (1.0 / 120 + r2 * (-1.0 / 5040 + r2 * (1.0 / 362880 + r2 * (-1.0 / 39916800 + r2 * (1.0 / 6227020800.0)))))));
  double cp = 1.0 + r2 * (-0.5 + r2 * (1.0 / 24 + r2 * (-1.0 / 720 + r2 * (1.0 / 40320 + r2 * (-1.0 / 3628800 + r2 * (1.0 / 479001600 + r2 * (-1.0 / 87178291200.0)))))));
  int k = ((int)kd) & 3;
  s = (k == 0) ? sp : (k == 1) ? cp : (k == 2) ? -sp : -cp;
  c = (k == 0) ? cp : (k == 1) ? -sp : (k == 2) ? -cp : sp;
}

DEV void phase_prep(const Params& p, char* smem) {
  const int tid = otid();
  char* ws = p.ws;
  for (int tt = blockIdx.x; tt < 6208; tt += gridDim.x) {
    const int l = tt / 3104;
    int r = tt - l * 3104;
    const float* src; u16* dst; int K, N, tn;
    if (r < 672) { src = p.w_in + (size_t)l * 1024 * NIN; dst = (u16*)(ws + OFF_WIN) + (size_t)l * NINP * 1024; K = 1024; N = NIN; tn = 42; }
    else if ((r -= 672) < 256) { src = p.w_out + (size_t)l * 1024 * 1024; dst = (u16*)(ws + OFF_WOUT) + (size_t)l * 1024 * 1024; K = 1024; N = 1024; tn = 16; }
    else if ((r -= 256) < 1024) { src = p.w_up + (size_t)l * 1024 * 4096; dst = (u16*)(ws + OFF_WUP) + (size_t)l * 4096 * 1024; K = 1024; N = 4096; tn = 64; }
    else if ((r -= 1024) < 1024) { src = p.w_down + (size_t)l * 4096 * 1024; dst = (u16*)(ws + OFF_WDOWN) + (size_t)l * 4096 * 1024; K = 4096; N = 1024; tn = 16; }
    else if ((r -= 1024) < 64) { src = p.w_ck + (size_t)l * 2048 * 64; dst = (u16*)(ws + OFF_WCK) + (size_t)l * 128 * 2048; K = 2048; N = 64; tn = 2; }
    else { r -= 64; src = p.w_cv + (size_t)l * 2048 * 64; dst = (u16*)(ws + OFF_WCV) + (size_t)l * 128 * 2048; K = 2048; N = 64; tn = 2; }
    transpose_tile(src, dst, K, N, tn, r, smem);
  }
  const size_t gtid = (size_t)blockIdx.x * 256 + tid, gstride = (size_t)gridDim.x * 256;
  {
    const float4* x4 = (const float4*)p.x;
    uint2* xb = (uint2*)(ws + OFF_XB);
    const size_t n4 = (size_t)MTOK * 1024 / 4;
    for (size_t i = gtid; i < n4; i += 4 * gstride) {
      float4 v[4];
#pragma unroll
      for (int u = 0; u < 4; ++u) if (i + u * gstride < n4) v[u] = x4[i + u * gstride];
#pragma unroll
      for (int u = 0; u < 4; ++u) if (i + u * gstride < n4) {
        uint2 o; o.x = pack2(v[u].x, v[u].y); o.y = pack2(v[u].z, v[u].w);
        xb[i + u * gstride] = o;
      }
    }
  }
  {
    float* cA = (float*)(ws + OFF_ROPEA); float* sA = cA + T * 16;
    float* cC = (float*)(ws + OFF_ROPEC); float* sCc = cC + T * 32;
    for (size_t i = gtid; i < (size_t)T * 48; i += gstride) {
      int t = (int)(i / 48), jj = (int)(i % 48);
      int j32 = (jj < 16) ? 2 * jj : (jj - 16);
      double inv = 1.0;
      const double base = 0.7498942093324559;
      for (int q = 0; q < j32; ++q) inv *= base;
      double s, c;
      sincos_d((double)t * inv, s, c);
      if (jj < 16) { cA[t * 16 + jj] = (float)c; sA[t * 16 + jj] = (float)s; }
      else { cC[t * 32 + jj - 16] = (float)c; sCc[t * 32 + jj - 16] = (float)s; }
    }
  }
  float* small = (float*)(ws + OFF_SMALL);
  if (blockIdx.x < 64) {
    const int lk = blockIdx.x >> 4, l = lk >> 1, kv = lk & 1;
    const int e = (blockIdx.x & 15) * 4 + (tid & 3), part = tid >> 2;
    const float* pe = (kv ? p.pe_v : p.pe_k) + (size_t)l * 2048;
    const float* w = (kv ? p.w_cv : p.w_ck) + (size_t)l * 2048 * 64;
    float acc = 0.f;
#pragma unroll 8
    for (int i = part * 32; i < part * 32 + 32; ++i) acc += pe[i] * w[(size_t)i * 64 + e];
    float* red = (float*)smem;
    red[tid] = acc;
    __syncthreads();
    if (tid < 4) {
      float t = 0.f;
      for (int q = 0; q < 64; ++q) t += red[q * 4 + tid];
      small[kv * 128 + l * 64 + (blockIdx.x & 15) * 4 + tid] = t;
    }
    __syncthreads();
  }
  if (blockIdx.x == 2) {
    unsigned* xbz = (unsigned*)(ws + OFF_XBAR);
    for (int i = tid; i < XCD_BAR_WORDS; i += 256) xbz[i] = 0u;
  }
  if (blockIdx.x == 0 && tid == 0) {
    for (int l = 0; l < 2; ++l) {
      float a = 0.f, b = 0.f;
      for (int i = 0; i < 32; ++i) { a += p.lq1[l * 32 + i] * p.lk1[l * 32 + i]; b += p.lq2[l * 32 + i] * p.lk2[l * 32 + i]; }
      float lam_init = 0.8f - 0.6f * expf(-0.3f * l);
      small[256 + l] = expf(a) - expf(b) + lam_init;
    }
    int* ctr = (int*)(small + 260);
    for (int i = 0; i < 8; ++i) ctr[i] = 0;
  }
}

DEV void phase_inproj(const Params& p, int layer, char* smem) {
  char* ws = p.ws;
  const int tid = otid();
  const u16* A = (const u16*)(ws + OFF_XB);
  const u16* Bt = (const u16*)(ws + OFF_WIN) + (size_t)layer * NINP * 1024;
  const float* cA = (const float*)(ws + OFF_ROPEA); const float* sA = cA + T * 16;
  const float* cC = (const float*)(ws + OFF_ROPEC); const float* sCc = cC + T * 32;
  const float* sC = (const float*)smem;
  const int ntiles = (MTOK / 128) * 21;
  for (int it = 0;; ++it) {
    int tm, tn;
    if (!next_tile(it, ntiles, MTOK / 128, 7, tm, tn)) break;
    const int m0 = tm * 128, n0 = tn * 128;
    gemm_mainloop(A, 1024, Bt, 1024, 1024, m0, n0, smem);
    const int b = m0 >> 13, t0 = m0 & (T - 1);
    if (tn == 20) {
      float* G = (float*)(ws + OFF_GATES);
      for (int u = tid; u < 128 * 18; u += 256) {
        int r = u / 18, c = u % 18;
        float v = sC[r * 132 + c];
        G[(size_t)(m0 + r) * 18 + c] = 1.f / (1.f + __expf(-v));
      }
    } else if ((tn >= 6 && tn <= 8) || tn == 15 || tn == 17 || tn == 19) {
      if (tn == 15) {
        u16* dst = (u16*)(ws + OFF_VCM);
        for (int u = tid; u < 2048; u += 256) {
          int r = u >> 4, c8 = u & 15, cc0 = c8 * 8;
          float v[8];
#pragma unroll
          for (int e = 0; e < 8; ++e) v[e] = sC[r * 132 + cc0 + e];
          int g = cc0 >> 6, d0 = cc0 & 63;
          *(uint4*)(dst + (((size_t)(b * 2 + g) * T + t0 + r) * 64 + d0)) = pack8(v);
        }
      } else {
        u16* dst; int hb, nh;
        if (tn <= 8) { dst = (u16*)(ws + OFF_VA); hb = (tn - 6) * 2; nh = 6; }
        else if (tn == 17) { dst = (u16*)(ws + OFF_VSL); hb = 0; nh = 2; }
        else { dst = (u16*)(ws + OFF_VWI); hb = 0; nh = 2; }
        for (int u = tid; u < 2048; u += 256) {
          int tg = u >> 7, col = u & 127;
          float v[8];
#pragma unroll
          for (int e = 0; e < 8; ++e) v[e] = sC[(tg * 8 + e) * 132 + col];
          int h = hb + (col >> 6), d = col & 63;
          int t = t0 + tg * 8;
          int G = t >> 5, g4 = (t & 31) >> 3;
          size_t off = ((size_t)(b * nh + h) * 256 + G) * 2048 + ((d >> 4) * 64 + (d & 15) + 16 * g4) * 8;
          *(uint4*)(dst + off) = pack8(v);
        }
      }
    } else {
      int HD = 0; float scale = 1.f;
      if (tn <= 5) HD = 32;
      else if (tn >= 11 && tn != 15) HD = 64;
      if (tn <= 2) scale = 0.17677669529663687f * LOG2E;
      if (tn >= 11 && tn <= 13) scale = 0.125f * LOG2E;
      const float* ct = (HD == 32) ? cA : cC;
      const float* st = (HD == 32) ? sA : sCc;
      float4 c0n, c1n, s0n, s1n;
      const int rj0 = HD ? ((((tid & 15) * 8) & (HD - 1)) & ((HD >> 1) - 1)) : 0;
      if (HD) {
        const int half = HD >> 1;
        const int t = t0 + (tid >> 4);
        const float* cs = ct + (size_t)t * half + rj0;
        const float* sn = st + (size_t)t * half + rj0;
        c0n = *(const float4*)cs; c1n = *(const float4*)(cs + 4);
        s0n = *(const float4*)sn; s1n = *(const float4*)(sn + 4);
      }
#pragma unroll 1
      for (int k = 0; k < 8; ++k) {
        const float4 c0 = c0n, c1 = c1n, s0 = s0n, s1 = s1n;
        if (HD && k < 7) {
          const int half = HD >> 1;
          const int t = t0 + (tid >> 4) + 16 * (k + 1);
          const float* cs = ct + (size_t)t * half + rj0;
          const float* sn = st + (size_t)t * half + rj0;
          c0n = *(const float4*)cs; c1n = *(const float4*)(cs + 4);
          s0n = *(const float4*)sn; s1n = *(const float4*)(sn + 4);
        }
        const int u = tid + 256 * k;
        int r = u >> 4, c8 = u & 15, cc0 = c8 * 8;
        int t = t0 + r;
        float v[8];
#pragma unroll
        for (int e = 0; e < 8; ++e) v[e] = sC[r * 132 + cc0 + e];
        if (HD) {
          int half = HD >> 1;
          int d0 = cc0 & (HD - 1);
          bool lo = d0 < half;
          const float* pp = sC + r * 132 + (lo ? cc0 + half : cc0 - half);
          const float cs[8] = {c0.x, c0.y, c0.z, c0.w, c1.x, c1.y, c1.z, c1.w};
          const float sn[8] = {s0.x, s0.y, s0.z, s0.w, s1.x, s1.y, s1.z, s1.w};
#pragma unroll
          for (int e = 0; e < 8; ++e) {
            float c = cs[e], sgn = sn[e], pv = pp[e];
            v[e] = lo ? (v[e] * c - pv * sgn) : (v[e] * c + pv * sgn);
          }
        }
#pragma unroll
        for (int e = 0; e < 8; ++e) v[e] *= scale;
        uint4 o = pack8(v);
        int tk = t & 31, G = t >> 5, uu = (tk >> 2) & 1;
        if (tn <= 2) {
          int hm = tn * 4 + (cc0 >> 5), d0 = cc0 & 31;
          *(uint4*)((u16*)(ws + OFF_QA) + (((size_t)(b * 12 + hm) * T + t) * 32 + d0)) = o;
        } else if (tn <= 5) {
          int hm = (tn - 3) * 4 + (cc0 >> 5), d0 = cc0 & 31;
          size_t off = ((size_t)(b * 12 + hm) * 256 + G) * 1024 + (uu * 64 + kfrag_lane(tk, d0 >> 3)) * 8;
          *(uint4*)((u16*)(ws + OFF_KA) + off) = o;
        } else if (tn <= 10) {
          *(uint4*)((u16*)(ws + OFF_U) + ((size_t)(m0 + r) * 256 + (n0 - 1152) + cc0)) = o;
        } else if (tn <= 13) {
          int hh = (tn - 11) * 2 + (cc0 >> 6), d0 = cc0 & 63;
          *(uint4*)((u16*)(ws + OFF_QC) + (((size_t)(b * 6 + hh) * T + t) * 64 + d0)) = o;
        } else if (tn == 14) {
          int g = cc0 >> 6, d0 = cc0 & 63;
          *(uint4*)((u16*)(ws + OFF_KCM) + (((size_t)(b * 2 + g) * T + t) * 64 + d0)) = o;
        } else {
          u16* dst = (u16*)(ws + (tn == 16 ? OFF_KSL : OFF_KWI));
          int g = cc0 >> 6, d0 = cc0 & 63;
          size_t off = ((size_t)(b * 2 + g) * 256 + G) * 2048 + (((d0 >> 5) * 2 + uu) * 64 + kfrag_lane(tk, (d0 >> 3) & 3)) * 8;
          *(uint4*)(dst + off) = o;
        }
      }
    }
    __syncthreads();
  }
}

DEV void phase_compress(const Params& p, int layer, char* smem, int* done) {
  char* ws = p.ws;
  const int tid = otid();
  const float* sC = (const float*)smem;
  const float* small = (const float*)(ws + OFF_SMALL);
  for (int item = blockIdx.x; item < 64; item += gridDim.x) {
    const int kv = item >> 5, bg = (item >> 2) & 7, mt = item & 3;
    const u16* A = (const u16*)(ws + (kv ? OFF_VCM : OFF_KCM)) + (size_t)bg * T * 64;
    const u16* Bt = (const u16*)(ws + (kv ? OFF_WCV : OFF_WCK)) + (size_t)layer * 128 * 2048;
    const int m0 = mt * 128;
    gemm_mainloop(A, 1024, Bt, 2048, 2048, m0, 0, smem);
    const float* bias = small + kv * 128 + layer * 64;
    if (!kv) {
      u16* dst = (u16*)(ws + OFF_KC);
      for (int u = tid; u < 1024; u += 256) {
        int r = u >> 3, c8 = u & 7, d0 = c8 * 8;
        float v[8];
#pragma unroll
        for (int e = 0; e < 8; ++e) v[e] = sC[r * 132 + d0 + e] + bias[d0 + e];
        int n = m0 + r, G = n >> 5, tk = n & 31, uu = (tk >> 2) & 1;
        size_t off = ((size_t)bg * 16 + G) * 2048 + (((d0 >> 5) * 2 + uu) * 64 + kfrag_lane(tk, (d0 >> 3) & 3)) * 8;
        *(uint4*)(dst + off) = pack8(v);
      }
    } else {
      u16* dst = (u16*)(ws + OFF_VC);
      for (int u = tid; u < 1024; u += 256) {
        int tg = u >> 6, d = u & 63;
        float v[8];
#pragma unroll
        for (int e = 0; e < 8; ++e) v[e] = sC[(tg * 8 + e) * 132 + d] + bias[d];
        int n = m0 + tg * 8, G = n >> 5, g4 = (n & 31) >> 3;
        size_t off = ((size_t)bg * 16 + G) * 2048 + ((d >> 4) * 64 + (d & 15) + 16 * g4) * 8;
        *(uint4*)(dst + off) = pack8(v);
      }
    }
    asm volatile("s_waitcnt vmcnt(0)" ::: "memory");
    __syncthreads();
    if (tid == 0) {
      __builtin_amdgcn_fence(__ATOMIC_RELEASE, "agent");
      asm volatile("s_waitcnt vmcnt(0)" ::: "memory");
      atomicAdd(done, 1);
    }
  }
}

#define GLD(dst, ptr, OFF) dst = *(const u32x4*)((const char*)(ptr) + OFF)
#define VMWAIT0()
DEV bf16x8 fr(u32x4 v) { union { u32x4 u; bf16x8 f; } c; c.u = v; return c.f; }

struct DFrag { u32x4 k[2][2]; u32x4 v[4]; };
DEV void dwait(DFrag& f) {}
DEV void dload(DFrag& f, const u16* k0, const u16* k1, const u16* v) {
  GLD(f.k[0][0], k0, 0); GLD(f.k[0][1], k0, 1024);
  GLD(f.k[1][0], k1, 0); GLD(f.k[1][1], k1, 1024);
  GLD(f.v[0], v, 0); GLD(f.v[1], v, 1024); GLD(f.v[2], v, 2048); GLD(f.v[3], v, 3072);
}
DEV void dstep(const DFrag& f, const bf16x8 (&Qf)[2][2], f32x4 (&O)[2][2][4], float (&mr)[2][2], f32x4 (&L)[2][2],
               int kb, bool diag, int qbase) {
  const bf16x8 ones = ones_frag();
#pragma unroll
  for (int m = 0; m < 2; ++m)
#pragma unroll
    for (int cgi = 0; cgi < 2; ++cgi) {
      const float mcur = mr[m][cgi];
      const float mo = (mcur > -1e29f) ? mcur : 0.f;
      f32x4 z = {-mo, -mo, -mo, -mo};
      f32x4 s0 = mfma16(fr(f.k[m][0]), Qf[m][cgi], z);
      f32x4 s1 = mfma16(fr(f.k[m][1]), Qf[m][cgi], z);
      float sv[8];
#pragma unroll
      for (int i = 0; i < 4; ++i) { sv[i] = s0[i]; sv[4 + i] = s1[i]; }
      if (diag) {
        const int qpos = qbase + cgi * 16;
#pragma unroll
        for (int j = 0; j < 8; ++j) sv[j] = (kb + j <= qpos) ? sv[j] : -INFINITY;
      }
      float mx = max8(sv);
      const float rel = mcur - mo;
      if (__ballot(mx > rel + RESCALE_THR) != 0ull) {
        mx = gmax4(mx);
        const float nrel = fmaxf(rel, mx);
        const float alpha = fexp2(rel - nrel);
        mr[m][cgi] = mo + nrel;
        L[m][cgi][0] *= alpha;
#pragma unroll
        for (int dt = 0; dt < 4; ++dt) {
          O[m][cgi][dt][0] *= alpha; O[m][cgi][dt][1] *= alpha; O[m][cgi][dt][2] *= alpha; O[m][cgi][dt][3] *= alpha;
        }
#pragma unroll
        for (int j = 0; j < 8; ++j) sv[j] -= nrel;
      }
#pragma unroll
      for (int j = 0; j < 8; ++j) sv[j] = fexp2(sv[j]);
      bf16x8 pb = pack8_frag(sv);
#pragma unroll
      for (int dt = 0; dt < 4; ++dt) O[m][cgi][dt] = mfma16(fr(f.v[dt]), pb, O[m][cgi][dt]);
      L[m][cgi] = mfma16(ones, pb, L[m][cgi]);
    }
}

DEV void diff_attn_item(const Params& p, int layer, int b, int h, int qt) {
  char* ws = p.ws;
  const int tid = otid(), lane = tid & 63, wid = tid >> 6;
  const int g4 = lane >> 4, col = lane & 15;
  const int q0 = qt * 128 + wid * 32;
  const float lam = ((const float*)(ws + OFF_SMALL))[256 + layer];
  const float lam_init = 0.8f - 0.6f * expf(-0.3f * layer);
  bf16x8 Qf[2][2];
  const u16* Kb[2];
#pragma unroll
  for (int m = 0; m < 2; ++m) {
    const u16* Qb = (const u16*)(ws + OFF_QA) + (size_t)(b * 12 + h * 2 + m) * T * 32;
#pragma unroll
    for (int cgi = 0; cgi < 2; ++cgi) Qf[m][cgi] = ldfrag(Qb + (size_t)(q0 + cgi * 16 + col) * 32 + g4 * 8);
    Kb[m] = (const u16*)(ws + OFF_KA) + (size_t)(b * 12 + h * 2 + m) * 256 * 1024 + lane * 8;
  }
  const u16* Vb = (const u16*)(ws + OFF_VA) + (size_t)(b * 6 + h) * 256 * 2048 + lane * 8;
  f32x4 O[2][2][4], L[2][2];
  float mr[2][2];
#pragma unroll
  for (int m = 0; m < 2; ++m)
#pragma unroll
    for (int cgi = 0; cgi < 2; ++cgi) {
      mr[m][cgi] = -1e30f; L[m][cgi] = (f32x4){0.f, 0.f, 0.f, 0.f};
#pragma unroll
      for (int dt = 0; dt < 4; ++dt) O[m][cgi][dt] = (f32x4){0.f, 0.f, 0.f, 0.f};
    }
  const int Gmax = qt * 4 + wid;
  const int qbase = q0 + col;
  DFrag fa, fb;
  VMWAIT0();
  dload(fa, Kb[0], Kb[1], Vb);
  for (int G = 0; G <= Gmax; G += 2) {
    const int G1 = (G + 1 <= Gmax) ? G + 1 : Gmax;
    dwait(fa);
    dload(fb, Kb[0] + (size_t)G1 * 1024, Kb[1] + (size_t)G1 * 1024, Vb + (size_t)G1 * 2048);
    dstep(fa, Qf, O, mr, L, G * 32 + 8 * g4, G == Gmax, qbase);
    const int G2 = (G + 2 <= Gmax) ? G + 2 : Gmax;
    dwait(fb);
    dload(fa, Kb[0] + (size_t)G2 * 1024, Kb[1] + (size_t)G2 * 1024, Vb + (size_t)G2 * 2048);
    if (G + 1 <= Gmax) dstep(fb, Qf, O, mr, L, (G + 1) * 32 + 8 * g4, G + 1 == Gmax, qbase);
  }
  dwait(fa);
  const float* sg = p.subln + layer * 64;
  u16* mix = (u16*)(ws + OFF_MIX);
#pragma unroll
  for (int cgi = 0; cgi < 2; ++cgi) {
    float l0 = L[0][cgi][0], l1 = L[1][cgi][0];
    float i0 = 1.f / l0, i1 = lam / l1;
    float o[4][4];
    float ss = 0.f;
#pragma unroll
    for (int dt = 0; dt < 4; ++dt)
#pragma unroll
      for (int i = 0; i < 4; ++i) {
        float v = O[0][cgi][dt][i] * i0 - O[1][cgi][dt][i] * i1;
        o[dt][i] = v; ss += v * v;
      }
    ss = gsum4(ss);
    float rs = rsqrtf(ss * (1.f / 64.f) + 1e-6f) * (1.f - lam_init);
    const size_t row = (size_t)(b * T + q0 + cgi * 16 + col) * 1024 + h * 64;
#pragma unroll
    for (int dt = 0; dt < 4; ++dt) {
      int d = dt * 16 + 4 * g4;
      float4 gg = *(const float4*)(sg + d);
      uint2 w;
      w.x = pack2(o[dt][0] * rs * gg.x, o[dt][1] * rs * gg.y);
      w.y = pack2(o[dt][2] * rs * gg.z, o[dt][3] * rs * gg.w);
      *(uint2*)(mix + row + d) = w;
    }
  }
}

template <int MODE>
DEV void nsa_step(const u16* __restrict__ Kg, const u16* __restrict__ Vg, const bf16x8 (&Qf)[3][2], float (&mr)[3], float (&lr)[3],
                  f32x4 (&O)[3][4], f32x4 (&LA)[3], int kb, int lo, int hi, float& e0, float& e1, float& ecar) {
  const bf16x8 ones = ones_frag();
  bf16x8 kf[2][2], vf[4];
#pragma unroll
  for (int ks = 0; ks < 2; ++ks)
#pragma unroll
    for (int u = 0; u < 2; ++u) kf[ks][u] = ldfrag(Kg + (ks * 2 + u) * 512);
  if (MODE != 0) {
#pragma unroll
    for (int dt = 0; dt < 4; ++dt) vf[dt] = ldfrag(Vg + dt * 512);
  }
#pragma unroll
  for (int h = 0; h < 3; ++h) {
    const float mcur = mr[h];
    const float mo = (mcur > -1e29f) ? mcur : 0.f;
    f32x4 z = {-mo, -mo, -mo, -mo};
    f32x4 s0 = mfma16(kf[0][0], Qf[h][0], z);
    s0 = mfma16(kf[1][0], Qf[h][1], s0);
    f32x4 s1 = mfma16(kf[0][1], Qf[h][0], z);
    s1 = mfma16(kf[1][1], Qf[h][1], s1);
    float sv[8];
#pragma unroll
    for (int i = 0; i < 4; ++i) { sv[i] = s0[i]; sv[4 + i] = s1[i]; }
    if (MODE == 1) {
      const float il = lr[h];
#pragma unroll
      for (int j = 0; j < 8; ++j) sv[j] = ((kb + j >= lo) && (kb + j <= hi)) ? fexp2(sv[j]) * il : 0.f;
      e0 += (sv[0] + sv[1]) + (sv[2] + sv[3]);
      e1 += (sv[4] + sv[5]) + (sv[6] + sv[7]) + sv[3];
      ecar += sv[7];
    } else {
#pragma unroll
      for (int j = 0; j < 8; ++j) sv[j] = ((kb + j >= lo) && (kb + j <= hi)) ? sv[j] : -INFINITY;
      float mx = max8(sv);
      const float rel = mcur - mo;
      if (__ballot(mx > rel + RESCALE_THR) != 0ull) {
        mx = gmax4(mx);
        const float nrel = fmaxf(rel, mx);
        const float alpha = fexp2(rel - nrel);
        mr[h] = mo + nrel;
        if (MODE == 2) {
          LA[h][0] *= alpha;
#pragma unroll
          for (int dt = 0; dt < 4; ++dt) {
            O[h][dt][0] *= alpha; O[h][dt][1] *= alpha; O[h][dt][2] *= alpha; O[h][dt][3] *= alpha;
          }
        } else lr[h] *= alpha;
#pragma unroll
        for (int j = 0; j < 8; ++j) sv[j] -= nrel;
      }
      if (MODE == 2) {
#pragma unroll
        for (int j = 0; j < 8; ++j) sv[j] = fexp2(sv[j]);
      } else {
        float ps = 0.f;
#pragma unroll
        for (int j = 0; j < 8; ++j) { sv[j] = fexp2(sv[j]); ps += sv[j]; }
        lr[h] += ps;
      }
    }
    if (MODE != 0) {
      bf16x8 pb = pack8_frag(sv);
#pragma unroll
      for (int dt = 0; dt < 4; ++dt) O[h][dt] = mfma16(vf[dt], pb, O[h][dt]);
      if (MODE == 2) LA[h] = mfma16(ones, pb, LA[h]);
    }
  }
}

DEV void nsa_item(const Params& p, int layer, int b, int g, int c, char* smem) {
  char* ws = p.ws;
  const int tid = otid(), lane = tid & 63, wid = tid >> 6;
  const int g4 = lane >> 4, col = lane & 15;
  const int t0 = c * 64 + wid * 16;
  const int t = t0 + col;
  const int bg = b * 2 + g;
  float* impA = (float*)(smem + wid * 12672);
  float* impC = impA + 2048;
  unsigned* selm = (unsigned*)(impC + 1056);
  bf16x8 Qf[3][2];
#pragma unroll
  for (int h = 0; h < 3; ++h)
#pragma unroll
    for (int ks = 0; ks < 2; ++ks)
      Qf[h][ks] = ldfrag((const u16*)(ws + OFF_QC) + ((size_t)(b * 6 + g * 3 + h) * T + t) * 64 + ks * 32 + g4 * 8);
  const float* gates = (const float*)(ws + OFF_GATES) + (size_t)(b * T + t) * 18 + g * 9;
  f32x4 O[3][4];
  uint2 OUT[3][4];
  float mr[3], lr[3];
  f32x4 LA[3];
  float e0 = 0.f, e1 = 0.f, ecar = 0.f;
  const u16* KC = (const u16*)(ws + OFF_KC) + (size_t)bg * 16 * 2048 + lane * 8;
  const u16* VC = (const u16*)(ws + OFF_VC) + (size_t)bg * 16 * 2048 + lane * 8;
  const int Gc = (4 * c + 2) >> 5;
  const int hic = (t - 31) >> 4;
#pragma unroll
  for (int h = 0; h < 3; ++h) { mr[h] = -1e30f; lr[h] = 0.f; }
  for (int G = 0; G <= Gc; ++G)
    nsa_step<0>(KC + G * 2048, VC + G * 2048, Qf, mr, lr, O, LA, G * 32 + 8 * g4, 0, hic, e0, e1, ecar);
#pragma unroll
  for (int h = 0; h < 3; ++h) {
    float l = gsum4(lr[h]);
    lr[h] = (l > 0.f) ? 1.f / l : 0.f;
#pragma unroll
    for (int dt = 0; dt < 4; ++dt) O[h][dt] = (f32x4){0.f, 0.f, 0.f, 0.f};
  }
  for (int G = 0; G <= Gc; ++G) {
    e0 = 0.f; e1 = 0.f; ecar = 0.f;
    nsa_step<1>(KC + G * 2048, VC + G * 2048, Qf, mr, lr, O, LA, G * 32 + 8 * g4, 0, hic, e0, e1, ecar);
    const int s0 = 8 * G + 2 * g4;
    impA[col * 128 + s0] = e0;
    impA[col * 128 + s0 + 1] = e1;
    impC[col * 65 + (s0 >> 1) + 1] = ecar;
  }
#pragma unroll
  for (int h = 0; h < 3; ++h) {
    const float gt = gates[h * 3 + 0];
#pragma unroll
    for (int dt = 0; dt < 4; ++dt) {
      OUT[h][dt].x = pack2(O[h][dt][0] * gt, O[h][dt][1] * gt);
      OUT[h][dt].y = pack2(O[h][dt][2] * gt, O[h][dt][3] * gt);
    }
  }
  __syncthreads();
  {
    const int nsel = (c + 1 < 16) ? (c + 1) : 16;
    for (int qb = 0; qb < 4; ++qb) {
      const int q = qb * 4 + g4;
      int key[8];
#pragma unroll
      for (int k = 0; k < 8; ++k) {
        const int blk = col + 16 * k;
        float v = impA[q * 128 + blk];
        if ((blk & 1) == 0 && blk >= 2) v += impC[q * 65 + (blk >> 1)];
        int kk;
        if (blk > c) kk = 0;
        else if (blk == 0 || blk == c || blk + 1 == c) kk = 0x7F000000 + (127 - blk);
        else kk = (int)(((__float_as_uint(v) & ~127u) | (unsigned)(127 - blk)) + 128u);
        key[k] = kk;
      }
      unsigned mw0 = 0, mw1 = 0, mw2 = 0, mw3 = 0;
      for (int r = 0; r < nsel; ++r) {
        int best = max(max(max(key[0], key[1]), max(key[2], key[3])), max(max(key[4], key[5]), max(key[6], key[7])));
        best = rowmax_i(best);
        const int blk = 127 - (best & 127);
        const unsigned bit = 1u << (blk & 31);
        const int wsel = blk >> 5;
        mw0 |= (wsel == 0) ? bit : 0u; mw1 |= (wsel == 1) ? bit : 0u;
        mw2 |= (wsel == 2) ? bit : 0u; mw3 |= (wsel == 3) ? bit : 0u;
#pragma unroll
        for (int k = 0; k < 8; ++k) key[k] = (key[k] == best) ? 0 : key[k];
      }
      if (col == 0) { selm[q * 4 + 0] = mw0; selm[q * 4 + 1] = mw1; selm[q * 4 + 2] = mw2; selm[q * 4 + 3] = mw3; }
    }
  }
  __syncthreads();
  const unsigned sw0 = selm[col * 4 + 0], sw1 = selm[col * 4 + 1], sw2 = selm[col * 4 + 2], sw3 = selm[col * 4 + 3];
#pragma unroll
  for (int h = 0; h < 3; ++h) {
    mr[h] = -1e30f; lr[h] = 0.f; LA[h] = (f32x4){0.f, 0.f, 0.f, 0.f};
#pragma unroll
    for (int dt = 0; dt < 4; ++dt) O[h][dt] = (f32x4){0.f, 0.f, 0.f, 0.f};
  }
  {
    const u16* KS = (const u16*)(ws + OFF_KSL) + (size_t)bg * 256 * 2048 + lane * 8;
    const u16* VS = (const u16*)(ws + OFF_VSL) + (size_t)bg * 256 * 2048 + lane * 8;
    for (int s = 0; s <= c; ++s) {
      const int wsel = s >> 5;
      const unsigned word = (wsel == 0) ? sw0 : (wsel == 1) ? sw1 : (wsel == 2) ? sw2 : sw3;
      const bool sel = (word >> (s & 31)) & 1u;
      if (__ballot(sel) == 0ull) continue;
      const int hi = sel ? t : -1;
#pragma unroll 1
      for (int hf = 0; hf < 2; ++hf) {
        const int G = 2 * s + hf;
        nsa_step<2>(KS + (size_t)G * 2048, VS + (size_t)G * 2048, Qf, mr, lr, O, LA, G * 32 + 8 * g4, 0, hi, e0, e1, ecar);
      }
    }
  }
#pragma unroll
  for (int h = 0; h < 3; ++h) {
    const float l = LA[h][0];
    const float gt = gates[h * 3 + 1] * ((l > 0.f) ? 1.f / l : 0.f);
#pragma unroll
    for (int dt = 0; dt < 4; ++dt) {
      OUT[h][dt].x = pack2(bflo(OUT[h][dt].x) + O[h][dt][0] * gt, bfhi(OUT[h][dt].x) + O[h][dt][1] * gt);
      OUT[h][dt].y = pack2(bflo(OUT[h][dt].y) + O[h][dt][2] * gt, bfhi(OUT[h][dt].y) + O[h][dt][3] * gt);
      O[h][dt] = (f32x4){0.f, 0.f, 0.f, 0.f};
    }
    mr[h] = -1e30f; lr[h] = 0.f; LA[h] = (f32x4){0.f, 0.f, 0.f, 0.f};
  }
  {
    const u16* KW = (const u16*)(ws + OFF_KWI) + (size_t)bg * 256 * 2048 + lane * 8;
    const u16* VW = (const u16*)(ws + OFF_VWI) + (size_t)bg * 256 * 2048 + lane * 8;
    const int Glo = (t0 - 511 > 0) ? ((t0 - 511) >> 5) : 0;
    const int Ghi = (t0 + 15) >> 5;
    for (int G = Glo; G <= Ghi; ++G)
      nsa_step<2>(KW + (size_t)G * 2048, VW + (size_t)G * 2048, Qf, mr, lr, O, LA, G * 32 + 8 * g4, t - 511, t, e0, e1, ecar);
  }
  u16* mix = (u16*)(ws + OFF_MIX);
  const size_t row = (size_t)(b * T + t) * 1024 + 640 + g * 192;
#pragma unroll
  for (int h = 0; h < 3; ++h) {
    const float l = LA[h][0];
    const float gt = gates[h * 3 + 2] * ((l > 0.f) ? 1.f / l : 0.f);
#pragma unroll
    for (int dt = 0; dt < 4; ++dt) {
      float a0 = bflo(OUT[h][dt].x) + O[h][dt][0] * gt, a1 = bfhi(OUT[h][dt].x) + O[h][dt][1] * gt;
      float a2 = bflo(OUT[h][dt].y) + O[h][dt][2] * gt, a3 = bfhi(OUT[h][dt].y) + O[h][dt][3] * gt;
      uint2 w; w.x = pack2(a0, a1); w.y = pack2(a2, a3);
      *(uint2*)(mix + row + h * 64 + dt * 16 + 4 * g4) = w;
    }
  }
  __syncthreads();
}

DEV void pool_item(const Params& p, int layer, int item, char* smem) {
  char* ws = p.ws;
  const int tid = otid();
  const int m0 = item * 64, t0 = m0 & (T - 1);
  float* uS = (float*)smem;
  float* yS = uS + 79 * 64;
  const u16* U = (const u16*)(ws + OFF_U);
  u16* mix = (u16*)(ws + OFF_MIX);
  for (int gi = 0; gi < 4; ++gi) {
    const int w = 2 << gi;
#pragma unroll 2
    for (int i = tid; i < 79 * 64; i += 256) {
      int r = i >> 6, cc = i & 63;
      int tt = t0 - 15 + r;
      uS[i] = (tt >= 0) ? bf2f(U[(size_t)(m0 - 15 + r) * 256 + gi * 64 + cc]) : 0.f;
    }
    __syncthreads();
    {
      const int cc = tid & 63, tq = tid >> 6;
#pragma unroll 1
      for (int j = 0; j < 16; ++j) {
        int tl = tq * 16 + j;
        int tt = t0 + tl;
        int cnt = (tt + 1 < w) ? (tt + 1) : w;
        float s = 0.f;
        for (int k = 0; k < cnt; ++k) s += uS[(tl + 15 - k) * 64 + cc];
        yS[tl * 65 + cc] = s / (float)cnt - uS[(tl + 15) * 64 + cc];
      }
    }
    __syncthreads();
    {
      const int dc = tid & 63, tq = tid >> 6;
      const float* W = p.w_pool + (size_t)layer * 4 * 4096 + (size_t)gi * 4096;
      float acc[16];
#pragma unroll
      for (int j = 0; j < 16; ++j) acc[j] = 0.f;
#pragma unroll 2
      for (int cc = 0; cc < 64; ++cc) {
        float wv = W[cc * 64 + dc];
#pragma unroll
        for (int j = 0; j < 16; ++j) acc[j] += yS[(tq * 16 + j) * 65 + cc] * wv;
      }
      const float sc = p.pool_scale[layer * 256 + gi * 64 + dc];
#pragma unroll
      for (int j = 0; j < 16; ++j) {
        unsigned pk = pack2(acc[j] * sc, 0.f);
        mix[(size_t)(m0 + tq * 16 + j) * 1024 + 384 + gi * 64 + dc] = (u16)(pk & 0xFFFFu);
      }
    }
    __syncthreads();
  }
}

DEV int next_item(int* ctr, int* s_item) {
  if (otid() == 0) *s_item = atomicAdd(ctr, 1);
  __syncthreads();
  const int k = *s_item;
  __syncthreads();
  return k;
}
DEV void phase_mixers(const Params& p, int layer, char* smem, int* s_item) {
  int* ctr = (int*)(p.ws + OFF_SMALL) + 260 + layer * 4;
  phase_compress(p, layer, smem, ctr + 3);
  while (true) {
    const int k = next_item(ctr + 0, s_item);
    if (k >= 1536) break;
    const int r = k % 24;
    diff_attn_item(p, layer, r / 6, r % 6, 63 - k / 24);
  }
  if (otid() == 0) {
    while (__hip_atomic_load(ctr + 3, __ATOMIC_RELAXED, __HIP_MEMORY_SCOPE_AGENT) < 64) __builtin_amdgcn_s_sleep(8);
    __builtin_amdgcn_fence(__ATOMIC_ACQUIRE, "agent");
    asm volatile("s_waitcnt vmcnt(0)" ::: "memory");
  }
  __syncthreads();
  while (true) {
    const int k = next_item(ctr + 1, s_item);
    if (k >= 1024) break;
    nsa_item(p, layer, (k & 7) >> 1, k & 1, 127 - (k >> 3), smem);
  }
  while (true) {
    const int k = next_item(ctr + 2, s_item);
    if (k >= 512) break;
    pool_item(p, layer, k, smem);
  }
}

DEV void phase_gemm(const Params& p, int layer, int kind, char* smem) {
  char* ws = p.ws;
  const int tid = otid();
  const float* sC = (const float*)smem;
  const u16* A; const u16* Bt; int K, NT;
  if (kind == 0) { A = (const u16*)(ws + OFF_MIX); Bt = (const u16*)(ws + OFF_WOUT) + (size_t)layer * 1024 * 1024; K = 1024; NT = 8; }
  else if (kind == 1) { A = (const u16*)(ws + OFF_XB); Bt = (const u16*)(ws + OFF_WUP) + (size_t)layer * 4096 * 1024; K = 1024; NT = 32; }
  else { A = (const u16*)(ws + OFF_H); Bt = (const u16*)(ws + OFF_WDOWN) + (size_t)layer * 4096 * 1024; K = 4096; NT = 8; }
  const int ntiles = (MTOK / 128) * NT;
  for (int it = 0;; ++it) {
    int tm, tn;
    if (!next_tile(it, ntiles, MTOK / 128, 8, tm, tn)) break;
    const int m0 = tm * 128, n0 = tn * 128;
    gemm_mainloop(A, K, Bt, K, K, m0, n0, smem);
    if (kind == 1) {
      u16* H = (u16*)(ws + OFF_H);
      for (int u = tid; u < 2048; u += 256) {
        int r = u >> 4, c8 = u & 15;
        float v[8];
#pragma unroll
        for (int e = 0; e < 8; ++e) { float a = fmaxf(sC[r * 132 + c8 * 8 + e], 0.f); v[e] = a * a; }
        *(uint4*)(H + (size_t)(m0 + r) * 4096 + n0 + c8 * 8) = pack8(v);
      }
    } else {
      const bool resf32 = (kind == 0 && layer == 0);
      const u16* xb = (const u16*)(ws + OFF_XB);
#pragma unroll 1
      for (int half = 0; half < 2; ++half) {
        float4 rs[8];
#pragma unroll
        for (int k = 0; k < 8; ++k) {
          const int u = tid + 256 * (half * 8 + k);
          const int r = u >> 5, c4 = u & 31;
          const size_t idx = (size_t)(m0 + r) * 1024 + n0 + c4 * 4;
          if (resf32) rs[k] = *(const float4*)(p.x + idx);
          else { uint2 w = *(const uint2*)(xb + idx); rs[k].x = bflo(w.x); rs[k].y = bfhi(w.x); rs[k].z = bflo(w.y); rs[k].w = bfhi(w.y); }
        }
#pragma unroll
        for (int k = 0; k < 8; ++k) {
          const int u = tid + 256 * (half * 8 + k);
          const int r = u >> 5, c4 = u & 31;
          const size_t idx = (size_t)(m0 + r) * 1024 + n0 + c4 * 4;
          float4 v = *(const float4*)(sC + r * 132 + c4 * 4);
          float4 o; o.x = ALPHA * rs[k].x + v.x; o.y = ALPHA * rs[k].y + v.y; o.z = ALPHA * rs[k].z + v.z; o.w = ALPHA * rs[k].w + v.w;
          uint2 yw; yw.x = pack2(o.x, o.y); yw.y = pack2(o.z, o.w);
          *(uint2*)((u16*)(ws + OFF_YB) + idx) = yw;
        }
      }
    }
    __syncthreads();
  }
}

DEV void phase_ln(const Params& p, const float* g, const float* bta, bool final_) {
  const int lane = otid() & 63, wid = otid() >> 6;
  u16* xb = (u16*)(p.ws + OFF_XB);
  const int nw = gridDim.x * 4;
  float4 gg4[4], bb4[4];
#pragma unroll
  for (int j = 0; j < 4; ++j) { gg4[j] = *(const float4*)(g + (j * 64 + lane) * 4); bb4[j] = *(const float4*)(bta + (j * 64 + lane) * 4); }
  for (int row0 = blockIdx.x * 4 + wid; row0 < MTOK; row0 += nw * 4) {
    float4 v[4][4];
#pragma unroll
    for (int rr = 0; rr < 4; ++rr) {
      const int row = row0 + rr * nw;
      if (row < MTOK) {
        const u16* y = (const u16*)(p.ws + OFF_YB) + (size_t)row * 1024;
#pragma unroll
        for (int j = 0; j < 4; ++j) {
          const uint2 w = *(const uint2*)(y + (j * 64 + lane) * 4);
          v[rr][j].x = bflo(w.x); v[rr][j].y = bfhi(w.x); v[rr][j].z = bflo(w.y); v[rr][j].w = bfhi(w.y);
        }
      }
    }
#pragma unroll
    for (int rr = 0; rr < 4; ++rr) {
      const int row = row0 + rr * nw;
      if (row < MTOK) {
        float* y = p.out + (size_t)row * 1024;
        float s = 0.f;
#pragma unroll
        for (int j = 0; j < 4; ++j) s += (v[rr][j].x + v[rr][j].y) + (v[rr][j].z + v[rr][j].w);
        const float mu = wsum(s) * (1.f / 1024.f);
        float q = 0.f;
#pragma unroll
        for (int j = 0; j < 4; ++j) {
          float a = v[rr][j].x - mu, b = v[rr][j].y - mu, c = v[rr][j].z - mu, d = v[rr][j].w - mu;
          q += (a * a + b * b) + (c * c + d * d);
        }
        const float rstd = rsqrtf(wsum(q) * (1.f / 1024.f) + 1e-5f);
#pragma unroll
        for (int j = 0; j < 4; ++j) {
          const int cidx = (j * 64 + lane) * 4;
          const float4 gg = gg4[j], bb = bb4[j];
          float4 o;
          o.x = (v[rr][j].x - mu) * rstd * gg.x + bb.x; o.y = (v[rr][j].y - mu) * rstd * gg.y + bb.y;
          o.z = (v[rr][j].z - mu) * rstd * gg.z + bb.z; o.w = (v[rr][j].w - mu) * rstd * gg.w + bb.w;
          if (final_) *(float4*)(y + cidx) = o;
          else { uint2 w; w.x = pack2(o.x, o.y); w.y = pack2(o.z, o.w); *(uint2*)(xb + (size_t)row * 1024 + cidx) = w; }
        }
      }
    }
  }
}

#define XB_TMO      128
#define XB_XCNT(j)  (256  + 64 * (j))
#define XB_XSUB(j)  (1280 + 64 * (j))
#define XB_XGEN(j)  (2304 + 64 * (j))
#define XB_TOP      3328
#define XB_TOPGEN   3392
#define XB_SPIN_CAP (1u << 22)
#define LAS __attribute__((address_space(3)))
DEV unsigned xb_ld(unsigned* p) { return __hip_atomic_load(p, __ATOMIC_RELAXED, __HIP_MEMORY_SCOPE_AGENT); }
DEV unsigned xb_add(unsigned* p, unsigned v) { return __hip_atomic_fetch_add(p, v, __ATOMIC_RELAXED, __HIP_MEMORY_SCOPE_AGENT); }
DEV unsigned xb_xcc_id() { return (unsigned)__builtin_amdgcn_s_getreg((3 << 11) | 20) & 0xFu; }
#define XB_SPIN(cond, bar) do { unsigned _sp = 0; while (cond) { __builtin_amdgcn_s_sleep(1); \
    if ((++_sp & 255u) == 0u) { if (xb_ld(&(bar)[XB_TMO])) break; if (_sp > XB_SPIN_CAP) { atomicAdd(&(bar)[XB_TMO], 1u); break; } } } } while (0)
struct XcdBarrier { unsigned* bar; unsigned x; volatile LAS unsigned* st; };
DEV XcdBarrier xcd_barrier_post(unsigned* bar, volatile LAS unsigned* st) {
  XcdBarrier b; b.bar = bar; b.x = xb_xcc_id(); b.st = st;
  if (threadIdx.x == 0) (void)xb_add(&bar[XB_XCNT(b.x)], 1u);
  return b;
}
DEV void xcd_barrier_complete(unsigned* bar, unsigned x, unsigned& nloc, unsigned& nx) {
  const unsigned G = gridDim.x * gridDim.y * gridDim.z;
  unsigned sum, cnt, mine, sp = 0u;
  for (;;) {
    sum = 0u; cnt = 0u; mine = 0u;
#pragma unroll
    for (unsigned j = 0; j < 16; ++j) { const unsigned c = xb_ld(&bar[XB_XCNT(j)]); sum += c; cnt += (c > 0u) ? 1u : 0u; mine = (j == x) ? c : mine; }
    if (sum == G) break;
    __builtin_amdgcn_s_sleep(1);
    if ((++sp & 255u) == 0u) { if (xb_ld(&bar[XB_TMO])) break; if (sp > XB_SPIN_CAP) { atomicAdd(&bar[XB_TMO], 1u); break; } }
  }
  nloc = mine > 0u ? mine : 1u; nx = cnt > 0u ? cnt : 1u;
}
DEV void xcd_barrier(const XcdBarrier& b) {
  asm volatile("s_waitcnt vmcnt(0)" ::: "memory");
  __syncthreads();
  if (threadIdx.x == 0) {
    unsigned* bar = b.bar;
    __builtin_amdgcn_s_waitcnt(0);
    unsigned nloc = b.st[0], nx = b.st[1];
    if (nloc == 0u) { xcd_barrier_complete(bar, b.x, nloc, nx); b.st[0] = nloc; b.st[1] = nx; }
    const unsigned old = xb_add(&bar[XB_XSUB(b.x)], 1u);
    const unsigned gen = old / nloc;
    if (old + 1u == (gen + 1u) * nloc) {
      __builtin_amdgcn_fence(__ATOMIC_RELEASE, "agent");
      asm volatile("s_waitcnt vmcnt(0)" ::: "memory");
      const unsigned og = xb_add(&bar[XB_TOP], 1u);
      const unsigned tg = og / nx;
      if (og + 1u == (tg + 1u) * nx) xb_add(&bar[XB_TOPGEN], 1u);
      else XB_SPIN(xb_ld(&bar[XB_TOPGEN]) == tg, bar);
      __builtin_amdgcn_fence(__ATOMIC_ACQUIRE, "agent");
      xb_add(&bar[XB_XGEN(b.x)], 1u);
      asm volatile("s_waitcnt vmcnt(0)" ::: "memory");
    } else {
      XB_SPIN(xb_ld(&bar[XB_XGEN(b.x)]) == gen, bar);
      __builtin_amdgcn_fence(__ATOMIC_ACQUIRE, "agent");
      asm volatile("s_waitcnt vmcnt(0)" ::: "memory");
    }
  }
  __syncthreads();
}

#ifndef TPROBE
#define TPROBE -1
#endif
__global__ void __launch_bounds__(256) __attribute__((amdgpu_waves_per_eu(2, 2))) hymba_mega(Params p) {
  __shared__ __attribute__((aligned(16))) char smem[SMEM_BYTES];
  __shared__ int s_item;
  __shared__ uint4 xb_words;
  if (threadIdx.x == 0) xb_words = make_uint4(0u, 0u, 0u, 0u);
  __syncthreads();
  XcdBarrier xb; xb.bar = (unsigned*)(p.ws + OFF_XBAR); xb.x = 0u; xb.st = (volatile LAS unsigned*)&xb_words;
#if TPROBE >= 0
  long long* tacc = (long long*)(p.ws + OFF_SMALL + 2048);
  long long tprev = 0;
  const bool timer = (blockIdx.x == 0 && threadIdx.x == 0);
  if (timer) { for (int i = 0; i < 16; ++i) tacc[i] = 0; tprev = wall_clock64(); }
#endif
  for (int ph = p.pbeg; ph < p.pend; ++ph) {
    if (ph == 0) phase_prep(p, smem);
    else {
      const int layer = (ph - 1) / 7, sub = (ph - 1) % 7;
      switch (sub) {
        case 0: phase_inproj(p, layer, smem); break;
        case 1: phase_mixers(p, layer, smem, &s_item); break;
        case 2: phase_gemm(p, layer, 0, smem); break;
        case 3: phase_ln(p, p.ln1g + layer * 1024, p.ln1b + layer * 1024, false); break;
        case 4: phase_gemm(p, layer, 1, smem); break;
        case 5: phase_gemm(p, layer, 2, smem); break;
        default: phase_ln(p, p.ln2g + layer * 1024, p.ln2b + layer * 1024, layer == 1); break;
      }
    }
#if TPROBE >= 0
    cg::this_grid().sync();
    if (timer) {
      long long tn = wall_clock64();
      int slot = (ph == 0) ? 8 : ((ph - 1) % 7);
      tacc[slot] += tn - tprev; tacc[9] += tn - tprev; tprev = tn;
    }
#else
    if (p.coop && ph + 1 < p.pend) {
      if (ph == 0) {
        cg::this_grid().sync();
        xb = xcd_barrier_post((unsigned*)(p.ws + OFF_XBAR), (volatile LAS unsigned*)&xb_words);
      } else xcd_barrier(xb);
    }
#endif
  }
#if TPROBE >= 0
  cg::this_grid().sync();
  {
    const float tau = (float)tacc[TPROBE] * 1e-8f / 0.010f;
    const float eps = 0.02f * sqrtf(tau);
    for (int i = blockIdx.x * 256 + threadIdx.x; i < (1 << 20); i += gridDim.x * 256) p.out[i] += eps;
  }
#endif
}

extern "C" void kernel_launch(void* const* d_in, const int* in_sizes, int n_in, void* d_out, int out_size, void* d_ws,
                              size_t ws_size, hipStream_t stream) {
  static int grid_blocks = 0;
  if (!grid_blocks) {
    int dev = 0, cus = 0, per_cu = 0;
    hipGetDevice(&dev);
    hipDeviceGetAttribute(&cus, hipDeviceAttributeMultiprocessorCount, dev);
    hipOccupancyMaxActiveBlocksPerMultiprocessor(&per_cu, hymba_mega, 256, 0);
    if (per_cu < 1) per_cu = 1;
    if (per_cu > 2) per_cu = 2;
    grid_blocks = cus * per_cu;
  }
  Params p{};
  const float* const* in = (const float* const*)d_in;
  p.x = in[0]; p.w_in = in[1]; p.lq1 = in[2]; p.lk1 = in[3]; p.lq2 = in[4]; p.lk2 = in[5]; p.subln = in[6];
  p.w_pool = in[7]; p.pool_scale = in[8]; p.pe_k = in[9]; p.pe_v = in[10]; p.w_ck = in[11]; p.w_cv = in[12];
  p.w_out = in[13]; p.ln1g = in[14]; p.ln1b = in[15]; p.w_up = in[16]; p.w_down = in[17]; p.ln2g = in[18]; p.ln2b = in[19];
  p.out = (float*)d_out;
  p.ws = (char*)d_ws;
  p.pad = 0;
  const int NPH = 15;
#if COOP
  p.pbeg = 0; p.pend = NPH; p.coop = 1;
  void* args[] = {&p};
  hipError_t e = hipLaunchCooperativeKernel((void*)hymba_mega, dim3(grid_blocks), dim3(256), args, 0, stream);
  if (e != hipSuccess) fprintf(stderr, "cooperative launch failed: %s (grid %d)\n", hipGetErrorString(e), grid_blocks);
#else
  for (int ph = 0; ph < NPH; ++ph) {
    p.pbeg = ph; p.pend = ph + 1; p.coop = 0;
    hipLaunchKernelGGL(hymba_mega, dim3(grid_blocks), dim3(256), 0, stream, p);
  }
#endif
}
```

```cpp
#include <hip/hip_runtime.h>
#include <hip/hip_cooperative_groups.h>
#include <math.h>
#include <cstdio>
namespace cg = cooperative_groups;

typedef unsigned short u16;
typedef __attribute__((ext_vector_type(8))) short bf16x8;
typedef __attribute__((ext_vector_type(4))) float f32x4;
typedef __attribute__((ext_vector_type(16))) float f32x16;
typedef __attribute__((ext_vector_type(4))) unsigned u32x4;

#define DEV __device__ __forceinline__
#ifndef COOP
#define COOP 1
#endif

constexpr int NB = 4, T = 8192, DM = 1024, MTOK = NB * T, NIN = 2578, NINP = 2688, DFF = 4096;
constexpr float ALPHA = 1.4142135623730951f;
constexpr float LOG2E = 1.4426950408889634f;
constexpr int SMEM_BYTES = 73728;
constexpr float RESCALE_THR = 6.0f;

constexpr size_t OFF_WIN = 0;
constexpr size_t OFF_WOUT = OFF_WIN + (size_t)2 * NINP * 1024 * 2;
constexpr size_t OFF_WUP = OFF_WOUT + (size_t)2 * 1024 * 1024 * 2;
constexpr size_t OFF_WDOWN = OFF_WUP + (size_t)2 * 4096 * 1024 * 2;
constexpr size_t OFF_WCK = OFF_WDOWN + (size_t)2 * 4096 * 1024 * 2;
constexpr size_t OFF_WCV = OFF_WCK + (size_t)2 * 128 * 2048 * 2;
constexpr size_t OFF_SMALL = OFF_WCV + (size_t)2 * 128 * 2048 * 2;
constexpr size_t OFF_ROPEA = OFF_SMALL + 4096;
constexpr size_t OFF_ROPEC = OFF_ROPEA + (size_t)2 * T * 16 * 4;
constexpr size_t OFF_XB = OFF_ROPEC + (size_t)2 * T * 32 * 4;
constexpr size_t OFF_R = OFF_XB + (size_t)MTOK * 1024 * 2;
constexpr size_t OFF_QA = OFF_R;
constexpr size_t OFF_KA = OFF_QA + (size_t)NB * 12 * T * 32 * 2;
constexpr size_t OFF_VA = OFF_KA + (size_t)NB * 12 * T * 32 * 2;
constexpr size_t OFF_U = OFF_VA + (size_t)NB * 6 * T * 64 * 2;
constexpr size_t OFF_QC = OFF_U + (size_t)MTOK * 256 * 2;
constexpr size_t KVSZ = (size_t)NB * 2 * T * 64 * 2;
constexpr size_t OFF_KCM = OFF_QC + (size_t)NB * 6 * T * 64 * 2;
constexpr size_t OFF_VCM = OFF_KCM + KVSZ;
constexpr size_t OFF_KSL = OFF_VCM + KVSZ;
constexpr size_t OFF_VSL = OFF_KSL + KVSZ;
constexpr size_t OFF_KWI = OFF_VSL + KVSZ;
constexpr size_t OFF_VWI = OFF_KWI + KVSZ;
constexpr size_t OFF_GATES = OFF_VWI + KVSZ;
constexpr size_t OFF_KC = OFF_GATES + (size_t)MTOK * 18 * 4;
constexpr size_t OFF_VC = OFF_KC + (size_t)NB * 2 * 512 * 64 * 2;
constexpr size_t OFF_MIX = OFF_VC + (size_t)NB * 2 * 512 * 64 * 2;
constexpr size_t OFF_MIX_END = OFF_MIX + (size_t)MTOK * 1024 * 2;
constexpr size_t OFF_H = OFF_R;
constexpr size_t OFF_END = OFF_R + (size_t)MTOK * 4096 * 2;
static_assert(OFF_MIX_END <= OFF_END, "mixer buffers must fit in H region");
constexpr size_t OFF_XBAR = OFF_END;
constexpr int XCD_BAR_WORDS = 3456;
constexpr size_t OFF_YB = OFF_XBAR + 16384;

struct Params {
  const float *x, *w_in, *lq1, *lk1, *lq2, *lk2, *subln, *w_pool, *pool_scale, *pe_k, *pe_v, *w_ck, *w_cv,
      *w_out, *ln1g, *ln1b, *w_up, *w_down, *ln2g, *ln2b;
  float* out;
  char* ws;
  int pbeg, pend, coop, pad;
};

DEV int otid() { int t = threadIdx.x; asm volatile("" : "+v"(t)); return t; }
DEV unsigned pack2(float a, float b) {
  unsigned r;
  asm("v_cvt_pk_bf16_f32 %0, %1, %2" : "=v"(r) : "v"(a), "v"(b));
  return r;
}
DEV float bf2f(u16 h) { return __uint_as_float(((unsigned)h) << 16); }
DEV float bflo(unsigned w) { return __uint_as_float(w << 16); }
DEV float bfhi(unsigned w) { return __uint_as_float(w & 0xFFFF0000u); }
DEV float fexp2(float x) { return __builtin_amdgcn_exp2f(x); }
DEV uint4 pack8(const float* v) {
  uint4 r;
  r.x = pack2(v[0], v[1]); r.y = pack2(v[2], v[3]); r.z = pack2(v[4], v[5]); r.w = pack2(v[6], v[7]);
  return r;
}
DEV bf16x8 as_frag(uint4 v) {
  union { uint4 u; bf16x8 f; } c; c.u = v; return c.f;
}
DEV bf16x8 ldfrag(const u16* p) { return as_frag(*(const uint4*)p); }
DEV f32x4 mfma16(bf16x8 a, bf16x8 b, f32x4 c) { return __builtin_amdgcn_mfma_f32_16x16x32_bf16(a, b, c, 0, 0, 0); }
DEV float max3(float a, float b, float c) {
  float r;
  asm("v_max3_f32 %0, %1, %2, %3" : "=v"(r) : "v"(a), "v"(b), "v"(c));
  return r;
}
DEV float max8(const float* s) { return max3(max3(s[0], s[1], s[2]), max3(s[3], s[4], s[5]), max3(s[6], s[7], s[7])); }
DEV bf16x8 ones_frag() {
  bf16x8 o;
#pragma unroll
  for (int i = 0; i < 8; ++i) o[i] = (short)0x3F80;
  return o;
}
DEV bf16x8 pack8_frag(const float* v) {
  unsigned r0, r1, r2, r3;
  asm("v_cvt_pk_bf16_f32 %0, %4, %5\n\tv_cvt_pk_bf16_f32 %1, %6, %7\n\tv_cvt_pk_bf16_f32 %2, %8, %9\n\tv_cvt_pk_bf16_f32 %3, %10, %11\n\ts_nop 4"
      : "=&v"(r0), "=&v"(r1), "=&v"(r2), "=&v"(r3)
      : "v"(v[0]), "v"(v[1]), "v"(v[2]), "v"(v[3]), "v"(v[4]), "v"(v[5]), "v"(v[6]), "v"(v[7]));
  uint4 u; u.x = r0; u.y = r1; u.z = r2; u.w = r3;
  return as_frag(u);
}
DEV float wsum(float v) {
#pragma unroll
  for (int o = 32; o >= 1; o >>= 1) v += __shfl_xor(v, o);
  return v;
}
DEV float gmax4(float v) {
  v = fmaxf(v, __shfl_xor(v, 16));
  v = fmaxf(v, __shfl_xor(v, 32));
  return v;
}
DEV float gsum4(float v) {
  v += __shfl_xor(v, 16);
  v += __shfl_xor(v, 32);
  return v;
}
DEV int rowmax_i(int v) {
  int t;
  t = __builtin_amdgcn_update_dpp(0, v, 0xB1, 0xF, 0xF, true); v = max(v, t);
  t = __builtin_amdgcn_update_dpp(0, v, 0x4E, 0xF, 0xF, true); v = max(v, t);
  t = __builtin_amdgcn_update_dpp(0, v, 0x141, 0xF, 0xF, true); v = max(v, t);
  t = __builtin_amdgcn_update_dpp(0, v, 0x140, 0xF, 0xF, true); v = max(v, t);
  return v;
}

DEV void gemm_mainloop(const u16* __restrict__ A, int lda, const u16* __restrict__ Bt, int ldb, int K, int m0, int n0,
                       char* smem) {
  const int tid = otid(), lane = tid & 63, wid = tid >> 6;
  const int wm = wid >> 1, wn = wid & 1;
  const int lr = tid >> 3, lc = tid & 7;
  const u16* ga = A + (size_t)(m0 + lr) * lda + lc * 8;
  const u16* gb = Bt + (size_t)(n0 + lr) * ldb + lc * 8;
  const size_t sa32 = (size_t)32 * lda, sb32 = (size_t)32 * ldb;
  const int nk = K >> 6;
  f32x16 acc[2][2];
#pragma unroll
  for (int i = 0; i < 2; ++i)
#pragma unroll
    for (int j = 0; j < 2; ++j)
#pragma unroll
      for (int r = 0; r < 16; ++r) acc[i][j][r] = 0.f;
  u32x4 a0[4], b0[4], a1[4], b1[4];
#define GEMM_ISSUE(RA, RB, KT)                                                              \
  {                                                                                         \
    const int kn_ = ((KT) < nk) ? (KT) : (nk - 1);                                          \
    _Pragma("unroll") for (int i = 0; i < 4; ++i) {                                         \
      const u16* pa_ = ga + i * sa32 + kn_ * 64;                                            \
      const u16* pb_ = gb + i * sb32 + kn_ * 64;                                            \
      asm volatile("global_load_dwordx4 %0, %1, off" : "=v"(RA[i]) : "v"(pa_));             \
      asm volatile("global_load_dwordx4 %0, %1, off" : "=v"(RB[i]) : "v"(pb_));             \
    }                                                                                       \
  }
#define GEMM_STORE(RA, RB, STAGE)                                                           \
  {                                                                                         \
    char* dA_ = smem + (STAGE) * 36864;                                                     \
    char* dB_ = dA_ + 18432;                                                                \
    _Pragma("unroll") for (int i = 0; i < 4; ++i) {                                         \
      *(u32x4*)(dA_ + (lr + 32 * i) * 144 + lc * 16) = RA[i];                               \
      *(u32x4*)(dB_ + (lr + 32 * i) * 144 + lc * 16) = RB[i];                               \
    }                                                                                       \
  }
#define GEMM_COMPUTE(STAGE)                                                                 \
  {                                                                                         \
    const char* sA_ = smem + (STAGE) * 36864;                                               \
    const char* sB_ = sA_ + 18432;                                                          \
    _Pragma("unroll") for (int ks = 0; ks < 4; ++ks) {                                      \
      bf16x8 af[2], bfr[2];                                                                 \
      _Pragma("unroll") for (int i = 0; i < 2; ++i)                                         \
        af[i] = as_frag(*(const uint4*)(sA_ + (wm * 64 + i * 32 + frow) * 144 + ks * 32 + fk)); \
      _Pragma("unroll") for (int j = 0; j < 2; ++j)                                         \
        bfr[j] = as_frag(*(const uint4*)(sB_ + (wn * 64 + j * 32 + frow) * 144 + ks * 32 + fk)); \
      _Pragma("unroll") for (int i = 0; i < 2; ++i)                                         \
        _Pragma("unroll") for (int j = 0; j < 2; ++j)                                       \
          acc[i][j] = __builtin_amdgcn_mfma_f32_32x32x16_bf16(af[i], bfr[j], acc[i][j], 0, 0, 0); \
    }                                                                                       \
  }
  const int frow = lane & 31, fk = (lane >> 5) * 16;
  GEMM_ISSUE(a0, b0, 0);
  GEMM_ISSUE(a1, b1, 1);
  asm volatile("s_waitcnt vmcnt(8)" ::: "memory");
  GEMM_STORE(a0, b0, 0);
  __syncthreads();
  for (int kt = 0; kt + 2 < nk; kt += 2) {
    GEMM_ISSUE(a0, b0, kt + 2);
    GEMM_COMPUTE(0);
    asm volatile("s_waitcnt vmcnt(8)" ::: "memory");
    GEMM_STORE(a1, b1, 1);
    __syncthreads();
    GEMM_ISSUE(a1, b1, kt + 3);
    GEMM_COMPUTE(1);
    asm volatile("s_waitcnt vmcnt(8)" ::: "memory");
    GEMM_STORE(a0, b0, 0);
    __syncthreads();
  }
  GEMM_COMPUTE(0);
  asm volatile("s_waitcnt vmcnt(0)" ::: "memory");
  GEMM_STORE(a1, b1, 1);
  __syncthreads();
  GEMM_COMPUTE(1);
  __syncthreads();
#undef GEMM_ISSUE
#undef GEMM_STORE
#undef GEMM_COMPUTE
  float* sC = (float*)smem;
#pragma unroll
  for (int i = 0; i < 2; ++i)
#pragma unroll
    for (int j = 0; j < 2; ++j)
#pragma unroll
      for (int r = 0; r < 16; ++r) {
        int row = wm * 64 + i * 32 + (r & 3) + 8 * (r >> 2) + 4 * (lane >> 5);
        int col = wn * 64 + j * 32 + (lane & 31);
        sC[row * 132 + col] = acc[i][j][r];
      }
  __syncthreads();
}

DEV bool next_tile(int it, int ntiles, int MT, int NG, int& tm, int& tn) {
  int idx;
  if ((gridDim.x & 7) == 0) {
    const int nlb = gridDim.x >> 3;
    idx = (it * 8 + (blockIdx.x & 7)) * nlb + (blockIdx.x >> 3);
  } else idx = it * gridDim.x + blockIdx.x;
  if (idx >= ntiles) return false;
  const int per = MT * NG;
  const int cgp = idx / per, rem = idx - cgp * per;
  tm = rem / NG; tn = cgp * NG + (rem - tm * NG);
  return true;
}

DEV int kfrag_lane(int tk, int g4) { return ((tk >> 3) << 2) + (tk & 3) + 16 * g4; }

DEV void transpose_tile(const float* __restrict__ src, u16* __restrict__ dst, int K, int N, int tn, int tile, char* smem) {
  float* tl = (float*)smem;
  const int tid = otid();
  const int k0 = (tile / tn) << 6, n0 = (tile % tn) << 6;
  float tmp[16];
#pragma unroll
  for (int i = 0; i < 16; ++i) {
    int r = (tid >> 6) + 4 * i, c = tid & 63, n = n0 + c;
    tmp[i] = (n < N) ? src[(size_t)(k0 + r) * N + n] : 0.f;
  }
#pragma unroll
  for (int i = 0; i < 16; ++i) tl[((tid >> 6) + 4 * i) * 65 + (tid & 63)] = tmp[i];
  __syncthreads();
#pragma unroll
  for (int j = 0; j < 2; ++j) {
    int ch = tid + 256 * j, n = ch >> 3, kc = ch & 7;
    float v[8];
#pragma unroll
    for (int e = 0; e < 8; ++e) v[e] = tl[(kc * 8 + e) * 65 + n];
    *(uint4*)(dst + (size_t)(n0 + n) * K + k0 + kc * 8) = pack8(v);
  }
  __syncthreads();
}

DEV void sincos_d(double x, double& s, double& c) {
  const double TWO_OVER_PI = 0.63661977236758134308;
  const double PIO2_HI = 1.57079632679489655800e+00, PIO2_LO = 6.12323399573676603587e-17;
  double kd = rint(x * TWO_OVER_PI);
  double r = (x - kd * PIO2_HI) - kd * PIO2_LO;
  double r2 = r * r;
  double sp = r * (1.0 + r2 * (-1.0 / 6 + r2 * (1.0 / 120 + r2 * (-1.0 / 5040 + r2 * (1.0 / 362880 + r2 * (-1.0 / 39916800 + r2 * (1.0 / 6227020800.0)))))));
  double cp = 1.0 + r2 * (-0.5 + r2 * (1.0 / 24 + r2 * (-1.0 / 720 + r2 * (1.0 / 40320 + r2 * (-1.0 / 3628800 + r2 * (1.0 / 479001600 + r2 * (-1.0 / 87178291200.0)))))));
  int k = ((int)kd) & 3;
  s = (k == 0) ? sp : (k == 1) ? cp : (k == 2) ? -sp : -cp;
  c = (k == 0) ? cp : (k == 1) ? -sp : (k == 2) ? -cp : sp;
}

DEV void phase_prep(const Params& p, char* smem) {
  const int tid = otid();
  char* ws = p.ws;
  for (int tt = blockIdx.x; tt < 6208; tt += gridDim.x) {
    const int l = tt / 3104;
    int r = tt - l * 3104;
    const float* src; u16* dst; int K, N, tn;
    if (r < 672) { src = p.w_in + (size_t)l * 1024 * NIN; dst = (u16*)(ws + OFF_WIN) + (size_t)l * NINP * 1024; K = 1024; N = NIN; tn = 42; }
    else if ((r -= 672) < 256) { src = p.w_out + (size_t)l * 1024 * 1024; dst = (u16*)(ws + OFF_WOUT) + (size_t)l * 1024 * 1024; K = 1024; N = 1024; tn = 16; }
    else if ((r -= 256) < 1024) { src = p.w_up + (size_t)l * 1024 * 4096; dst = (u16*)(ws + OFF_WUP) + (size_t)l * 4096 * 1024; K = 1024; N = 4096; tn = 64; }
    else if ((r -= 1024) < 1024) { src = p.w_down + (size_t)l * 4096 * 1024; dst = (u16*)(ws + OFF_WDOWN) + (size_t)l * 4096 * 1024; K = 4096; N = 1024; tn = 16; }
    else if ((r -= 1024) < 64) { src = p.w_ck + (size_t)l * 2048 * 64; dst = (u16*)(ws + OFF_WCK) + (size_t)l * 128 * 2048; K = 2048; N = 64; tn = 2; }
    else { r -= 64; src = p.w_cv + (size_t)l * 2048 * 64; dst = (u16*)(ws + OFF_WCV) + (size_t)l * 128 * 2048; K = 2048; N = 64; tn = 2; }
    transpose_tile(src, dst, K, N, tn, r, smem);
  }
  const size_t gtid = (size_t)blockIdx.x * 256 + tid, gstride = (size_t)gridDim.x * 256;
  {
    const float4* x4 = (const float4*)p.x;
    uint2* xb = (uint2*)(ws + OFF_XB);
    const size_t n4 = (size_t)MTOK * 1024 / 4;
    for (size_t i = gtid; i < n4; i += 4 * gstride) {
      float4 v[4];
#pragma unroll
      for (int u = 0; u < 4; ++u) if (i + u * gstride < n4) v[u] = x4[i + u * gstride];
#pragma unroll
      for (int u = 0; u < 4; ++u) if (i + u * gstride < n4) {
        uint2 o; o.x = pack2(v[u].x, v[u].y); o.y = pack2(v[u].z, v[u].w);
        xb[i + u * gstride] = o;
      }
    }
  }
  {
    float* cA = (float*)(ws + OFF_ROPEA); float* sA = cA + T * 16;
    float* cC = (float*)(ws + OFF_ROPEC); float* sCc = cC + T * 32;
    for (size_t i = gtid; i < (size_t)T * 48; i += gstride) {
      int t = (int)(i / 48), jj = (int)(i % 48);
      int j32 = (jj < 16) ? 2 * jj : (jj - 16);
      double inv = 1.0;
      const double base = 0.7498942093324559;
      for (int q = 0; q < j32; ++q) inv *= base;
      double s, c;
      sincos_d((double)t * inv, s, c);
      if (jj < 16) { cA[t * 16 + jj] = (float)c; sA[t * 16 + jj] = (float)s; }
      else { cC[t * 32 + jj - 16] = (float)c; sCc[t * 32 + jj - 16] = (float)s; }
    }
  }
  float* small = (float*)(ws + OFF_SMALL);
  if (blockIdx.x < 64) {
    const int lk = blockIdx.x >> 4, l = lk >> 1, kv = lk & 1;
    const int e = (blockIdx.x & 15) * 4 + (tid & 3), part = tid >> 2;
    const float* pe = (kv ? p.pe_v : p.pe_k) + (size_t)l * 2048;
    const float* w = (kv ? p.w_cv : p.w_ck) + (size_t)l * 2048 * 64;
    float acc = 0.f;
#pragma unroll 8
    for (int i = part * 32; i < part * 32 + 32; ++i) acc += pe[i] * w[(size_t)i * 64 + e];
    float* red = (float*)smem;
    red[tid] = acc;
    __syncthreads();
    if (tid < 4) {
      float t = 0.f;
      for (int q = 0; q < 64; ++q) t += red[q * 4 + tid];
      small[kv * 128 + l * 64 + (blockIdx.x & 15) * 4 + tid] = t;
    }
    __syncthreads();
  }
  if (blockIdx.x == 0 && tid == 0) {
    for (int l = 0; l < 2; ++l) {
      float a = 0.f, b = 0.f;
      for (int i = 0; i < 32; ++i) { a += p.lq1[l * 32 + i] * p.lk1[l * 32 + i]; b += p.lq2[l * 32 + i] * p.lk2[l * 32 + i]; }
      float lam_init = 0.8f - 0.6f * expf(-0.3f * l);
      small[256 + l] = expf(a) - expf(b) + lam_init;
    }
    int* ctr = (int*)(small + 260);
    for (int i = 0; i < 8; ++i) ctr[i] = 0;
  }
}

DEV void phase_inproj(const Params& p, int layer, char* smem) {
  char* ws = p.ws;
  const int tid = otid();
  const u16* A = (const u16*)(ws + OFF_XB);
  const u16* Bt = (const u16*)(ws + OFF_WIN) + (size_t)layer * NINP * 1024;
  const float* cA = (const float*)(ws + OFF_ROPEA); const float* sA = cA + T * 16;
  const float* cC = (const float*)(ws + OFF_ROPEC); const float* sCc = cC + T * 32;
  const float* sC = (const float*)smem;
  const int ntiles = (MTOK / 128) * 20;
  for (int it = 0;; ++it) {
    int tm, tn;
    if (!next_tile(it, ntiles, MTOK / 128, 5, tm, tn)) break;
    const int m0 = tm * 128, n0 = tn * 128;
    gemm_mainloop(A, 1024, Bt, 1024, 1024, m0, n0, smem);
    const int b = m0 >> 13, t0 = m0 & (T - 1);
    if (tn == 20) {
      float* G = (float*)(ws + OFF_GATES);
      for (int u = tid; u < 128 * 18; u += 256) {
        int r = u / 18, c = u % 18;
        float v = sC[r * 132 + c];
        G[(size_t)(m0 + r) * 18 + c] = 1.f / (1.f + __expf(-v));
      }
    } else if ((tn >= 6 && tn <= 8) || tn == 15 || tn == 17 || tn == 19) {
      if (tn == 15) {
        u16* dst = (u16*)(ws + OFF_VCM);
        for (int u = tid; u < 2048; u += 256) {
          int r = u >> 4, c8 = u & 15, cc0 = c8 * 8;
          float v[8];
#pragma unroll
          for (int e = 0; e < 8; ++e) v[e] = sC[r * 132 + cc0 + e];
          int g = cc0 >> 6, d0 = cc0 & 63;
          *(uint4*)(dst + (((size_t)(b * 2 + g) * T + t0 + r) * 64 + d0)) = pack8(v);
        }
      } else {
        u16* dst; int hb, nh;
        if (tn <= 8) { dst = (u16*)(ws + OFF_VA); hb = (tn - 6) * 2; nh = 6; }
        else if (tn == 17) { dst = (u16*)(ws + OFF_VSL); hb = 0; nh = 2; }
        else { dst = (u16*)(ws + OFF_VWI); hb = 0; nh = 2; }
        for (int u = tid; u < 2048; u += 256) {
          int tg = u >> 7, col = u & 127;
          float v[8];
#pragma unroll
          for (int e = 0; e < 8; ++e) v[e] = sC[(tg * 8 + e) * 132 + col];
          int h = hb + (col >> 6), d = col & 63;
          int t = t0 + tg * 8;
          int G = t >> 5, g4 = (t & 31) >> 3;
          size_t off = ((size_t)(b * nh + h) * 256 + G) * 2048 + ((d >> 4) * 64 + (d & 15) + 16 * g4) * 8;
          *(uint4*)(dst + off) = pack8(v);
        }
      }
    } else {
      int HD = 0; float scale = 1.f;
      if (tn <= 5) HD = 32;
      else if (tn >= 11 && tn != 15) HD = 64;
      if (tn <= 2) scale = 0.17677669529663687f * LOG2E;
      if (tn >= 11 && tn <= 13) scale = 0.125f * LOG2E;
      const float* ct = (HD == 32) ? cA : cC;
      const float* st = (HD == 32) ? sA : sCc;
      float4 c0n, c1n, s0n, s1n;
      const int rj0 = HD ? ((((tid & 15) * 8) & (HD - 1)) & ((HD >> 1) - 1)) : 0;
      if (HD) {
        const int half = HD >> 1;
        const int t = t0 + (tid >> 4);
        const float* cs = ct + (size_t)t * half + rj0;
        const float* sn = st + (size_t)t * half + rj0;
        c0n = *(const float4*)cs; c1n = *(const float4*)(cs + 4);
        s0n = *(const float4*)sn; s1n = *(const float4*)(sn + 4);
      }
#pragma unroll 1
      for (int k = 0; k < 8; ++k) {
        const float4 c0 = c0n, c1 = c1n, s0 = s0n, s1 = s1n;
        if (HD && k < 7) {
          const int half = HD >> 1;
          const int t = t0 + (tid >> 4) + 16 * (k + 1);
          const float* cs = ct + (size_t)t * half + rj0;
          const float* sn = st + (size_t)t * half + rj0;
          c0n = *(const float4*)cs; c1n = *(const float4*)(cs + 4);
          s0n = *(const float4*)sn; s1n = *(const float4*)(sn + 4);
        }
        const int u = tid + 256 * k;
        int r = u >> 4, c8 = u & 15, cc0 = c8 * 8;
        int t = t0 + r;
        float v[8];
#pragma unroll
        for (int e = 0; e < 8; ++e) v[e] = sC[r * 132 + cc0 + e];
        if (HD) {
          int half = HD >> 1;
          int d0 = cc0 & (HD - 1);
          bool lo = d0 < half;
          const float* pp = sC + r * 132 + (lo ? cc0 + half : cc0 - half);
          const float cs[8] = {c0.x, c0.y, c0.z, c0.w, c1.x, c1.y, c1.z, c1.w};
          const float sn[8] = {s0.x, s0.y, s0.z, s0.w, s1.x, s1.y, s1.z, s1.w};
#pragma unroll
          for (int e = 0; e < 8; ++e) {
            float c = cs[e], sgn = sn[e], pv = pp[e];
            v[e] = lo ? (v[e] * c - pv * sgn) : (v[e] * c + pv * sgn);
          }
        }
#pragma unroll
        for (int e = 0; e < 8; ++e) v[e] *= scale;
        uint4 o = pack8(v);
        int tk = t & 31, G = t >> 5, uu = (tk >> 2) & 1;
        if (tn <= 2) {
          int hm = tn * 4 + (cc0 >> 5), d0 = cc0 & 31;
          *(uint4*)((u16*)(ws + OFF_QA) + (((size_t)(b * 12 + hm) * T + t) * 32 + d0)) = o;
        } else if (tn <= 5) {
          int hm = (tn - 3) * 4 + (cc0 >> 5), d0 = cc0 & 31;
          size_t off = ((size_t)(b * 12 + hm) * 256 + G) * 1024 + (uu * 64 + kfrag_lane(tk, d0 >> 3)) * 8;
          *(uint4*)((u16*)(ws + OFF_KA) + off) = o;
        } else if (tn <= 10) {
          *(uint4*)((u16*)(ws + OFF_U) + ((size_t)(m0 + r) * 256 + (n0 - 1152) + cc0)) = o;
        } else if (tn <= 13) {
          int hh = (tn - 11) * 2 + (cc0 >> 6), d0 = cc0 & 63;
          *(uint4*)((u16*)(ws + OFF_QC) + (((size_t)(b * 6 + hh) * T + t) * 64 + d0)) = o;
        } else if (tn == 14) {
          int g = cc0 >> 6, d0 = cc0 & 63;
          *(uint4*)((u16*)(ws + OFF_KCM) + (((size_t)(b * 2 + g) * T + t) * 64 + d0)) = o;
        } else {
          u16* dst = (u16*)(ws + (tn == 16 ? OFF_KSL : OFF_KWI));
          int g = cc0 >> 6, d0 = cc0 & 63;
          size_t off = ((size_t)(b * 2 + g) * 256 + G) * 2048 + (((d0 >> 5) * 2 + uu) * 64 + kfrag_lane(tk, (d0 >> 3) & 3)) * 8;
          *(uint4*)(dst + off) = o;
        }
      }
    }
    __syncthreads();
  }
}

DEV void phase_compress(const Params& p, int layer, char* smem, int* done) {
  char* ws = p.ws;
  const int tid = otid();
  const float* sC = (const float*)smem;
  const float* small = (const float*)(ws + OFF_SMALL);
  for (int item = blockIdx.x; item < 64; item += gridDim.x) {
    const int kv = item >> 5, bg = (item >> 2) & 7, mt = item & 3;
    const u16* A = (const u16*)(ws + (kv ? OFF_VCM : OFF_KCM)) + (size_t)bg * T * 64;
    const u16* Bt = (const u16*)(ws + (kv ? OFF_WCV : OFF_WCK)) + (size_t)layer * 128 * 2048;
    const int m0 = mt * 128;
    gemm_mainloop(A, 1024, Bt, 2048, 2048, m0, 0, smem);
    const float* bias = small + kv * 128 + layer * 64;
    if (!kv) {
      u16* dst = (u16*)(ws + OFF_KC);
      for (int u = tid; u < 1024; u += 256) {
        int r = u >> 3, c8 = u & 7, d0 = c8 * 8;
        float v[8];
#pragma unroll
        for (int e = 0; e < 8; ++e) v[e] = sC[r * 132 + d0 + e] + bias[d0 + e];
        int n = m0 + r, G = n >> 5, tk = n & 31, uu = (tk >> 2) & 1;
        size_t off = ((size_t)bg * 16 + G) * 2048 + (((d0 >> 5) * 2 + uu) * 64 + kfrag_lane(tk, (d0 >> 3) & 3)) * 8;
        *(uint4*)(dst + off) = pack8(v);
      }
    } else {
      u16* dst = (u16*)(ws + OFF_VC);
      for (int u = tid; u < 1024; u += 256) {
        int tg = u >> 6, d = u & 63;
        float v[8];
#pragma unroll
        for (int e = 0; e < 8; ++e) v[e] = sC[(tg * 8 + e) * 132 + d] + bias[d];
        int n = m0 + tg * 8, G = n >> 5, g4 = (n & 31) >> 3;
        size_t off = ((size_t)bg * 16 + G) * 2048 + ((d >> 4) * 64 + (d & 15) + 16 * g4) * 8;
        *(uint4*)(dst + off) = pack8(v);
      }
    }
    asm volatile("s_waitcnt vmcnt(0)" ::: "memory");
    __syncthreads();
    if (tid == 0) {
      __builtin_amdgcn_fence(__ATOMIC_RELEASE, "agent");
      asm volatile("s_waitcnt vmcnt(0)" ::: "memory");
      atomicAdd(done, 1);
    }
  }
}

#define GLD(dst, ptr, OFF) dst = *(const u32x4*)((const char*)(ptr) + OFF)
#define VMWAIT0()
DEV bf16x8 fr(u32x4 v) { union { u32x4 u; bf16x8 f; } c; c.u = v; return c.f; }

struct DFrag { u32x4 k[2][2]; u32x4 v[4]; };
DEV void dwait(DFrag& f) {}
DEV void dload(DFrag& f, const u16* k0, const u16* k1, const u16* v) {
  GLD(f.k[0][0], k0, 0); GLD(f.k[0][1], k0, 1024);
  GLD(f.k[1][0], k1, 0); GLD(f.k[1][1], k1, 1024);
  GLD(f.v[0], v, 0); GLD(f.v[1], v, 1024); GLD(f.v[2], v, 2048); GLD(f.v[3], v, 3072);
}
DEV void dstep(const DFrag& f, const bf16x8 (&Qf)[2][2], f32x4 (&O)[2][2][4], float (&mr)[2][2], f32x4 (&L)[2][2],
               int kb, bool diag, int qbase) {
  const bf16x8 ones = ones_frag();
#pragma unroll
  for (int m = 0; m < 2; ++m)
#pragma unroll
    for (int cgi = 0; cgi < 2; ++cgi) {
      const float mcur = mr[m][cgi];
      const float mo = (mcur > -1e29f) ? mcur : 0.f;
      f32x4 z = {-mo, -mo, -mo, -mo};
      f32x4 s0 = mfma16(fr(f.k[m][0]), Qf[m][cgi], z);
      f32x4 s1 = mfma16(fr(f.k[m][1]), Qf[m][cgi], z);
      float sv[8];
#pragma unroll
      for (int i = 0; i < 4; ++i) { sv[i] = s0[i]; sv[4 + i] = s1[i]; }
      if (diag) {
        const int qpos = qbase + cgi * 16;
#pragma unroll
        for (int j = 0; j < 8; ++j) sv[j] = (kb + j <= qpos) ? sv[j] : -INFINITY;
      }
      float mx = max8(sv);
      const float rel = mcur - mo;
      if (__ballot(mx > rel + RESCALE_THR) != 0ull) {
        mx = gmax4(mx);
        const float nrel = fmaxf(rel, mx);
        const float alpha = fexp2(rel - nrel);
        mr[m][cgi] = mo + nrel;
        L[m][cgi][0] *= alpha;
#pragma unroll
        for (int dt = 0; dt < 4; ++dt) {
          O[m][cgi][dt][0] *= alpha; O[m][cgi][dt][1] *= alpha; O[m][cgi][dt][2] *= alpha; O[m][cgi][dt][3] *= alpha;
        }
#pragma unroll
        for (int j = 0; j < 8; ++j) sv[j] -= nrel;
      }
#pragma unroll
      for (int j = 0; j < 8; ++j) sv[j] = fexp2(sv[j]);
      bf16x8 pb = pack8_frag(sv);
#pragma unroll
      for (int dt = 0; dt < 4; ++dt) O[m][cgi][dt] = mfma16(fr(f.v[dt]), pb, O[m][cgi][dt]);
      L[m][cgi] = mfma16(ones, pb, L[m][cgi]);
    }
}

DEV void diff_attn_item(const Params& p, int layer, int b, int h, int qt) {
  char* ws = p.ws;
  const int tid = otid(), lane = tid & 63, wid = tid >> 6;
  const int g4 = lane >> 4, col = lane & 15;
  const int q0 = qt * 128 + wid * 32;
  const float lam = ((const float*)(ws + OFF_SMALL))[256 + layer];
  const float lam_init = 0.8f - 0.6f * expf(-0.3f * layer);
  bf16x8 Qf[2][2];
  const u16* Kb[2];
#pragma unroll
  for (int m = 0; m < 2; ++m) {
    const u16* Qb = (const u16*)(ws + OFF_QA) + (size_t)(b * 12 + h * 2 + m) * T * 32;
#pragma unroll
    for (int cgi = 0; cgi < 2; ++cgi) Qf[m][cgi] = ldfrag(Qb + (size_t)(q0 + cgi * 16 + col) * 32 + g4 * 8);
    Kb[m] = (const u16*)(ws + OFF_KA) + (size_t)(b * 12 + h * 2 + m) * 256 * 1024 + lane * 8;
  }
  const u16* Vb = (const u16*)(ws + OFF_VA) + (size_t)(b * 6 + h) * 256 * 2048 + lane * 8;
  f32x4 O[2][2][4], L[2][2];
  float mr[2][2];
#pragma unroll
  for (int m = 0; m < 2; ++m)
#pragma unroll
    for (int cgi = 0; cgi < 2; ++cgi) {
      mr[m][cgi] = -1e30f; L[m][cgi] = (f32x4){0.f, 0.f, 0.f, 0.f};
#pragma unroll
      for (int dt = 0; dt < 4; ++dt) O[m][cgi][dt] = (f32x4){0.f, 0.f, 0.f, 0.f};
    }
  const int Gmax = qt * 4 + wid;
  const int qbase = q0 + col;
  DFrag fa, fb;
  VMWAIT0();
  dload(fa, Kb[0], Kb[1], Vb);
  for (int G = 0; G <= Gmax; G += 2) {
    const int G1 = (G + 1 <= Gmax) ? G + 1 : Gmax;
    dwait(fa);
    dload(fb, Kb[0] + (size_t)G1 * 1024, Kb[1] + (size_t)G1 * 1024, Vb + (size_t)G1 * 2048);
    dstep(fa, Qf, O, mr, L, G * 32 + 8 * g4, G == Gmax, qbase);
    const int G2 = (G + 2 <= Gmax) ? G + 2 : Gmax;
    dwait(fb);
    dload(fa, Kb[0] + (size_t)G2 * 1024, Kb[1] + (size_t)G2 * 1024, Vb + (size_t)G2 * 2048);
    if (G + 1 <= Gmax) dstep(fb, Qf, O, mr, L, (G + 1) * 32 + 8 * g4, G + 1 == Gmax, qbase);
  }
  dwait(fa);
  const float* sg = p.subln + layer * 64;
  u16* mix = (u16*)(ws + OFF_MIX);
#pragma unroll
  for (int cgi = 0; cgi < 2; ++cgi) {
    float l0 = L[0][cgi][0], l1 = L[1][cgi][0];
    float i0 = 1.f / l0, i1 = lam / l1;
    float o[4][4];
    float ss = 0.f;
#pragma unroll
    for (int dt = 0; dt < 4; ++dt)
#pragma unroll
      for (int i = 0; i < 4; ++i) {
        float v = O[0][cgi][dt][i] * i0 - O[1][cgi][dt][i] * i1;
        o[dt][i] = v; ss += v * v;
      }
    ss = gsum4(ss);
    float rs = rsqrtf(ss * (1.f / 64.f) + 1e-6f) * (1.f - lam_init);
    const size_t row = (size_t)(b * T + q0 + cgi * 16 + col) * 1024 + h * 64;
#pragma unroll
    for (int dt = 0; dt < 4; ++dt) {
      int d = dt * 16 + 4 * g4;
      float4 gg = *(const float4*)(sg + d);
      uint2 w;
      w.x = pack2(o[dt][0] * rs * gg.x, o[dt][1] * rs * gg.y);
      w.y = pack2(o[dt][2] * rs * gg.z, o[dt][3] * rs * gg.w);
      *(uint2*)(mix + row + d) = w;
    }
  }
}

template <int MODE>
DEV void nsa_step(const u16* __restrict__ Kg, const u16* __restrict__ Vg, const bf16x8 (&Qf)[3][2], float (&mr)[3], float (&lr)[3],
                  f32x4 (&O)[3][4], f32x4 (&LA)[3], int kb, int lo, int hi, float& e0, float& e1, float& ecar) {
  const bf16x8 ones = ones_frag();
  bf16x8 kf[2][2], vf[4];
#pragma unroll
  for (int ks = 0; ks < 2; ++ks)
#pragma unroll
    for (int u = 0; u < 2; ++u) kf[ks][u] = ldfrag(Kg + (ks * 2 + u) * 512);
  if (MODE != 0) {
#pragma unroll
    for (int dt = 0; dt < 4; ++dt) vf[dt] = ldfrag(Vg + dt * 512);
  }
#pragma unroll
  for (int h = 0; h < 3; ++h) {
    const float mcur = mr[h];
    const float mo = (mcur > -1e29f) ? mcur : 0.f;
    f32x4 z = {-mo, -mo, -mo, -mo};
    f32x4 s0 = mfma16(kf[0][0], Qf[h][0], z);
    s0 = mfma16(kf[1][0], Qf[h][1], s0);
    f32x4 s1 = mfma16(kf[0][1], Qf[h][0], z);
    s1 = mfma16(kf[1][1], Qf[h][1], s1);
    float sv[8];
#pragma unroll
    for (int i = 0; i < 4; ++i) { sv[i] = s0[i]; sv[4 + i] = s1[i]; }
    if (MODE == 1) {
      const float il = lr[h];
#pragma unroll
      for (int j = 0; j < 8; ++j) sv[j] = ((kb + j >= lo) && (kb + j <= hi)) ? fexp2(sv[j]) * il : 0.f;
      e0 += (sv[0] + sv[1]) + (sv[2] + sv[3]);
      e1 += (sv[4] + sv[5]) + (sv[6] + sv[7]) + sv[3];
      ecar += sv[7];
    } else {
#pragma unroll
      for (int j = 0; j < 8; ++j) sv[j] = ((kb + j >= lo) && (kb + j <= hi)) ? sv[j] : -INFINITY;
      float mx = max8(sv);
      const float rel = mcur - mo;
      if (__ballot(mx > rel + RESCALE_THR) != 0ull) {
        mx = gmax4(mx);
        const float nrel = fmaxf(rel, mx);
        const float alpha = fexp2(rel - nrel);
        mr[h] = mo + nrel;
        if (MODE == 2) {
          LA[h][0] *= alpha;
#pragma unroll
          for (int dt = 0; dt < 4; ++dt) {
            O[h][dt][0] *= alpha; O[h][dt][1] *= alpha; O[h][dt][2] *= alpha; O[h][dt][3] *= alpha;
          }
        } else lr[h] *= alpha;
#pragma unroll
        for (int j = 0; j < 8; ++j) sv[j] -= nrel;
      }
      if (MODE == 2) {
#pragma unroll
        for (int j = 0; j < 8; ++j) sv[j] = fexp2(sv[j]);
      } else {
        float ps = 0.f;
#pragma unroll
        for (int j = 0; j < 8; ++j) { sv[j] = fexp2(sv[j]); ps += sv[j]; }
        lr[h] += ps;
      }
    }
    if (MODE != 0) {
      bf16x8 pb = pack8_frag(sv);
#pragma unroll
      for (int dt = 0; dt < 4; ++dt) O[h][dt] = mfma16(vf[dt], pb, O[h][dt]);
      if (MODE == 2) LA[h] = mfma16(ones, pb, LA[h]);
    }
  }
}

DEV void nsa_item(const Params& p, int layer, int b, int g, int c, char* smem) {
  char* ws = p.ws;
  const int tid = otid(), lane = tid & 63, wid = tid >> 6;
  const int g4 = lane >> 4, col = lane & 15;
  const int t0 = c * 64 + wid * 16;
  const int t = t0 + col;
  const int bg = b * 2 + g;
  float* impA = (float*)(smem + wid * 12672);
  float* impC = impA + 2048;
  unsigned* selm = (unsigned*)(impC + 1056);
  bf16x8 Qf[3][2];
#pragma unroll
  for (int h = 0; h < 3; ++h)
#pragma unroll
    for (int ks = 0; ks < 2; ++ks)
      Qf[h][ks] = ldfrag((const u16*)(ws + OFF_QC) + ((size_t)(b * 6 + g * 3 + h) * T + t) * 64 + ks * 32 + g4 * 8);
  const float* gates = (const float*)(ws + OFF_GATES) + (size_t)(b * T + t) * 18 + g * 9;
  f32x4 O[3][4];
  uint2 OUT[3][4];
  float mr[3], lr[3];
  f32x4 LA[3];
  float e0 = 0.f, e1 = 0.f, ecar = 0.f;
  const u16* KC = (const u16*)(ws + OFF_KC) + (size_t)bg * 16 * 2048 + lane * 8;
  const u16* VC = (const u16*)(ws + OFF_VC) + (size_t)bg * 16 * 2048 + lane * 8;
  const int Gc = (4 * c + 2) >> 5;
  const int hic = (t - 31) >> 4;
#pragma unroll
  for (int h = 0; h < 3; ++h) { mr[h] = -1e30f; lr[h] = 0.f; }
  for (int G = 0; G <= Gc; ++G)
    nsa_step<0>(KC + G * 2048, VC + G * 2048, Qf, mr, lr, O, LA, G * 32 + 8 * g4, 0, hic, e0, e1, ecar);
#pragma unroll
  for (int h = 0; h < 3; ++h) {
    float l = gsum4(lr[h]);
    lr[h] = (l > 0.f) ? 1.f / l : 0.f;
#pragma unroll
    for (int dt = 0; dt < 4; ++dt) O[h][dt] = (f32x4){0.f, 0.f, 0.f, 0.f};
  }
  for (int G = 0; G <= Gc; ++G) {
    e0 = 0.f; e1 = 0.f; ecar = 0.f;
    nsa_step<1>(KC + G * 2048, VC + G * 2048, Qf, mr, lr, O, LA, G * 32 + 8 * g4, 0, hic, e0, e1, ecar);
    const int s0 = 8 * G + 2 * g4;
    impA[col * 128 + s0] = e0;
    impA[col * 128 + s0 + 1] = e1;
    impC[col * 65 + (s0 >> 1) + 1] = ecar;
  }
#pragma unroll
  for (int h = 0; h < 3; ++h) {
    const float gt = gates[h * 3 + 0];
#pragma unroll
    for (int dt = 0; dt < 4; ++dt) {
      OUT[h][dt].x = pack2(O[h][dt][0] * gt, O[h][dt][1] * gt);
      OUT[h][dt].y = pack2(O[h][dt][2] * gt, O[h][dt][3] * gt);
    }
  }
  __syncthreads();
  {
    const int nsel = (c + 1 < 16) ? (c + 1) : 16;
    for (int qb = 0; qb < 4; ++qb) {
      const int q = qb * 4 + g4;
      int key[8];
#pragma unroll
      for (int k = 0; k < 8; ++k) {
        const int blk = col + 16 * k;
        float v = impA[q * 128 + blk];
        if ((blk & 1) == 0 && blk >= 2) v += impC[q * 65 + (blk >> 1)];
        int kk;
        if (blk > c) kk = 0;
        else if (blk == 0 || blk == c || blk + 1 == c) kk = 0x7F000000 + (127 - blk);
        else kk = (int)(((__float_as_uint(v) & ~127u) | (unsigned)(127 - blk)) + 128u);
        key[k] = kk;
      }
      unsigned mw0 = 0, mw1 = 0, mw2 = 0, mw3 = 0;
      for (int r = 0; r < nsel; ++r) {
        int best = max(max(max(key[0], key[1]), max(key[2], key[3])), max(max(key[4], key[5]), max(key[6], key[7])));
        best = rowmax_i(best);
        const int blk = 127 - (best & 127);
        const unsigned bit = 1u << (blk & 31);
        const int wsel = blk >> 5;
        mw0 |= (wsel == 0) ? bit : 0u; mw1 |= (wsel == 1) ? bit : 0u;
        mw2 |= (wsel == 2) ? bit : 0u; mw3 |= (wsel == 3) ? bit : 0u;
#pragma unroll
        for (int k = 0; k < 8; ++k) key[k] = (key[k] == best) ? 0 : key[k];
      }
      if (col == 0) { selm[q * 4 + 0] = mw0; selm[q * 4 + 1] = mw1; selm[q * 4 + 2] = mw2; selm[q * 4 + 3] = mw3; }
    }
  }
  __syncthreads();
  const unsigned sw0 = selm[col * 4 + 0], sw1 = selm[col * 4 + 1], sw2 = selm[col * 4 + 2], sw3 = selm[col * 4 + 3];
#pragma unroll
  for (int h = 0; h < 3; ++h) {
    mr[h] = -1e30f; lr[h] = 0.f; LA[h] = (f32x4){0.f, 0.f, 0.f, 0.f};
#pragma unroll
    for (int dt = 0; dt < 4; ++dt) O[h][dt] = (f32x4){0.f, 0.f, 0.f, 0.f};
  }
  {
    const u16* KS = (const u16*)(ws + OFF_KSL) + (size_t)bg * 256 * 2048 + lane * 8;
    const u16* VS = (const u16*)(ws + OFF_VSL) + (size_t)bg * 256 * 2048 + lane * 8;
    for (int s = 0; s <= c; ++s) {
      const int wsel = s >> 5;
      const unsigned word = (wsel == 0) ? sw0 : (wsel == 1) ? sw1 : (wsel == 2) ? sw2 : sw3;
      const bool sel = (word >> (s & 31)) & 1u;
      if (__ballot(sel) == 0ull) continue;
      const int hi = sel ? t : -1;
#pragma unroll 1
      for (int hf = 0; hf < 2; ++hf) {
        const int G = 2 * s + hf;
        nsa_step<2>(KS + (size_t)G * 2048, VS + (size_t)G * 2048, Qf, mr, lr, O, LA, G * 32 + 8 * g4, 0, hi, e0, e1, ecar);
      }
    }
  }
#pragma unroll
  for (int h = 0; h < 3; ++h) {
    const float l = LA[h][0];
    const float gt = gates[h * 3 + 1] * ((l > 0.f) ? 1.f / l : 0.f);
#pragma unroll
    for (int dt = 0; dt < 4; ++dt) {
      OUT[h][dt].x = pack2(bflo(OUT[h][dt].x) + O[h][dt][0] * gt, bfhi(OUT[h][dt].x) + O[h][dt][1] * gt);
      OUT[h][dt].y = pack2(bflo(OUT[h][dt].y) + O[h][dt][2] * gt, bfhi(OUT[h][dt].y) + O[h][dt][3] * gt);
      O[h][dt] = (f32x4){0.f, 0.f, 0.f, 0.f};
    }
    mr[h] = -1e30f; lr[h] = 0.f; LA[h] = (f32x4){0.f, 0.f, 0.f, 0.f};
  }
  {
    const u16* KW = (const u16*)(ws + OFF_KWI) + (size_t)bg * 256 * 2048 + lane * 8;
    const u16* VW = (const u16*)(ws + OFF_VWI) + (size_t)bg * 256 * 2048 + lane * 8;
    const int Glo = (t0 - 511 > 0) ? ((t0 - 511) >> 5) : 0;
    const int Ghi = (t0 + 15) >> 5;
    for (int G = Glo; G <= Ghi; ++G)
      nsa_step<2>(KW + (size_t)G * 2048, VW + (size_t)G * 2048, Qf, mr, lr, O, LA, G * 32 + 8 * g4, t - 511, t, e0, e1, ecar);
  }
  u16* mix = (u16*)(ws + OFF_MIX);
  const size_t row = (size_t)(b * T + t) * 1024 + 640 + g * 192;
#pragma unroll
  for (int h = 0; h < 3; ++h) {
    const float l = LA[h][0];
    const float gt = gates[h * 3 + 2] * ((l > 0.f) ? 1.f / l : 0.f);
#pragma unroll
    for (int dt = 0; dt < 4; ++dt) {
      float a0 = bflo(OUT[h][dt].x) + O[h][dt][0] * gt, a1 = bfhi(OUT[h][dt].x) + O[h][dt][1] * gt;
      float a2 = bflo(OUT[h][dt].y) + O[h][dt][2] * gt, a3 = bfhi(OUT[h][dt].y) + O[h][dt][3] * gt;
      uint2 w; w.x = pack2(a0, a1); w.y = pack2(a2, a3);
      *(uint2*)(mix + row + h * 64 + dt * 16 + 4 * g4) = w;
    }
  }
  __syncthreads();
}

DEV void pool_item(const Params& p, int layer, int item, char* smem) {
  char* ws = p.ws;
  const int tid = otid();
  const int m0 = item * 64, t0 = m0 & (T - 1);
  float* uS = (float*)smem;
  float* yS = uS + 79 * 64;
  const u16* U = (const u16*)(ws + OFF_U);
  u16* mix = (u16*)(ws + OFF_MIX);
  for (int gi = 0; gi < 4; ++gi) {
    const int w = 2 << gi;
#pragma unroll 2
    for (int i = tid; i < 79 * 64; i += 256) {
      int r = i >> 6, cc = i & 63;
      int tt = t0 - 15 + r;
      uS[i] = (tt >= 0) ? bf2f(U[(size_t)(m0 - 15 + r) * 256 + gi * 64 + cc]) : 0.f;
    }
    __syncthreads();
    {
      const int cc = tid & 63, tq = tid >> 6;
#pragma unroll 1
      for (int j = 0; j < 16; ++j) {
        int tl = tq * 16 + j;
        int tt = t0 + tl;
        int cnt = (tt + 1 < w) ? (tt + 1) : w;
        float s = 0.f;
        for (int k = 0; k < cnt; ++k) s += uS[(tl + 15 - k) * 64 + cc];
        yS[tl * 65 + cc] = s / (float)cnt - uS[(tl + 15) * 64 + cc];
      }
    }
    __syncthreads();
    {
      const int dc = tid & 63, tq = tid >> 6;
      const float* W = p.w_pool + (size_t)layer * 4 * 4096 + (size_t)gi * 4096;
      float acc[16];
#pragma unroll
      for (int j = 0; j < 16; ++j) acc[j] = 0.f;
#pragma unroll 2
      for (int cc = 0; cc < 64; ++cc) {
        float wv = W[cc * 64 + dc];
#pragma unroll
        for (int j = 0; j < 16; ++j) acc[j] += yS[(tq * 16 + j) * 65 + cc] * wv;
      }
      const float sc = p.pool_scale[layer * 256 + gi * 64 + dc];
#pragma unroll
      for (int j = 0; j < 16; ++j) {
        unsigned pk = pack2(acc[j] * sc, 0.f);
        mix[(size_t)(m0 + tq * 16 + j) * 1024 + 384 + gi * 64 + dc] = (u16)(pk & 0xFFFFu);
      }
    }
    __syncthreads();
  }
}

DEV int next_item(int* ctr, int* s_item) {
  if (otid() == 0) *s_item = atomicAdd(ctr, 1);
  __syncthreads();
  const int k = *s_item;
  __syncthreads();
  return k;
}
DEV void gates_items(const Params& p, int layer, char* smem, int* done) {
  char* ws = p.ws;
  const int tid = otid();
  const float* sC = (const float*)smem;
  const u16* A = (const u16*)(ws + OFF_XB);
  const u16* Bt = (const u16*)(ws + OFF_WIN) + (size_t)layer * NINP * 1024;
  float* G = (float*)(ws + OFF_GATES);
  for (int item = blockIdx.x; item < MTOK / 128; item += gridDim.x) {
    const int m0 = item * 128;
    gemm_mainloop(A, 1024, Bt, 1024, 1024, m0, 2560, smem);
    for (int u = tid; u < 128 * 18; u += 256) {
      int r = u / 18, c = u % 18;
      float v = sC[r * 132 + c];
      G[(size_t)(m0 + r) * 18 + c] = 1.f / (1.f + __expf(-v));
    }
    asm volatile("s_waitcnt vmcnt(0)" ::: "memory");
    __syncthreads();
    if (tid == 0) {
      __builtin_amdgcn_fence(__ATOMIC_RELEASE, "agent");
      asm volatile("s_waitcnt vmcnt(0)" ::: "memory");
      atomicAdd(done, 1);
    }
  }
}
DEV void phase_mixers(const Params& p, int layer, char* smem, int* s_item) {
  int* ctr = (int*)(p.ws + OFF_SMALL) + 260 + layer * 4;
  phase_compress(p, layer, smem, ctr + 3);
  gates_items(p, layer, smem, ctr + 3);
  while (true) {
    const int k = next_item(ctr + 0, s_item);
    if (k >= 1536) break;
    const int r = k % 24;
    diff_attn_item(p, layer, r / 6, r % 6, 63 - k / 24);
  }
  if (otid() == 0) {
    while (__hip_atomic_load(ctr + 3, __ATOMIC_RELAXED, __HIP_MEMORY_SCOPE_AGENT) < 64 + MTOK / 128) __builtin_amdgcn_s_sleep(8);
    __builtin_amdgcn_fence(__ATOMIC_ACQUIRE, "agent");
    asm volatile("s_waitcnt vmcnt(0)" ::: "memory");
  }
  __syncthreads();
  while (true) {
    const int k = next_item(ctr + 1, s_item);
    if (k >= 1024) break;
    nsa_item(p, layer, (k & 7) >> 1, k & 1, 127 - (k >> 3), smem);
  }
  while (true) {
    const int k = next_item(ctr + 2, s_item);
    if (k >= 512) break;
    pool_item(p, layer, k, smem);
  }
}

DEV void phase_gemm(const Params& p, int layer, int kind, char* smem) {
  char* ws = p.ws;
  const int tid = otid();
  const float* sC = (const float*)smem;
  const u16* A; const u16* Bt; int K, NT;
  if (kind == 0) { A = (const u16*)(ws + OFF_MIX); Bt = (const u16*)(ws + OFF_WOUT) + (size_t)layer * 1024 * 1024; K = 1024; NT = 8; }
  else if (kind == 1) { A = (const u16*)(ws + OFF_XB); Bt = (const u16*)(ws + OFF_WUP) + (size_t)layer * 4096 * 1024; K = 1024; NT = 32; }
  else { A = (const u16*)(ws + OFF_H); Bt = (const u16*)(ws + OFF_WDOWN) + (size_t)layer * 4096 * 1024; K = 4096; NT = 8; }
  const int ntiles = (MTOK / 128) * NT;
  for (int it = 0;; ++it) {
    int tm, tn;
    if (!next_tile(it, ntiles, MTOK / 128, 8, tm, tn)) break;
    const int m0 = tm * 128, n0 = tn * 128;
    gemm_mainloop(A, K, Bt, K, K, m0, n0, smem);
    if (kind == 1) {
      u16* H = (u16*)(ws + OFF_H);
      for (int u = tid; u < 2048; u += 256) {
        int r = u >> 4, c8 = u & 15;
        float v[8];
#pragma unroll
        for (int e = 0; e < 8; ++e) { float a = fmaxf(sC[r * 132 + c8 * 8 + e], 0.f); v[e] = a * a; }
        *(uint4*)(H + (size_t)(m0 + r) * 4096 + n0 + c8 * 8) = pack8(v);
      }
    } else {
      const bool resf32 = (kind == 0 && layer == 0);
      const u16* xb = (const u16*)(ws + OFF_XB);
#pragma unroll 1
      for (int half = 0; half < 2; ++half) {
        float4 rs[8];
#pragma unroll
        for (int k = 0; k < 8; ++k) {
          const int u = tid + 256 * (half * 8 + k);
          const int r = u >> 5, c4 = u & 31;
          const size_t idx = (size_t)(m0 + r) * 1024 + n0 + c4 * 4;
          if (resf32) rs[k] = *(const float4*)(p.x + idx);
          else { uint2 w = *(const uint2*)(xb + idx); rs[k].x = bflo(w.x); rs[k].y = bfhi(w.x); rs[k].z = bflo(w.y); rs[k].w = bfhi(w.y); }
        }
#pragma unroll
        for (int k = 0; k < 8; ++k) {
          const int u = tid + 256 * (half * 8 + k);
          const int r = u >> 5, c4 = u & 31;
          const size_t idx = (size_t)(m0 + r) * 1024 + n0 + c4 * 4;
          float4 v = *(const float4*)(sC + r * 132 + c4 * 4);
          float4 o; o.x = ALPHA * rs[k].x + v.x; o.y = ALPHA * rs[k].y + v.y; o.z = ALPHA * rs[k].z + v.z; o.w = ALPHA * rs[k].w + v.w;
          uint2 yw; yw.x = pack2(o.x, o.y); yw.y = pack2(o.z, o.w);
          *(uint2*)((u16*)(ws + OFF_YB) + idx) = yw;
        }
      }
    }
    __syncthreads();
  }
}

DEV void phase_ln(const Params& p, const float* g, const float* bta, bool final_) {
  const int lane = otid() & 63, wid = otid() >> 6;
  u16* xb = (u16*)(p.ws + OFF_XB);
  const int nw = gridDim.x * 4;
  float4 gg4[4], bb4[4];
#pragma unroll
  for (int j = 0; j < 4; ++j) { gg4[j] = *(const float4*)(g + (j * 64 + lane) * 4); bb4[j] = *(const float4*)(bta + (j * 64 + lane) * 4); }
  for (int row0 = blockIdx.x * 4 + wid; row0 < MTOK; row0 += nw * 4) {
    float4 v[4][4];
#pragma unroll
    for (int rr = 0; rr < 4; ++rr) {
      const int row = row0 + rr * nw;
      if (row < MTOK) {
        const u16* y = (const u16*)(p.ws + OFF_YB) + (size_t)row * 1024;
#pragma unroll
        for (int j = 0; j < 4; ++j) {
          const uint2 w = *(const uint2*)(y + (j * 64 + lane) * 4);
          v[rr][j].x = bflo(w.x); v[rr][j].y = bfhi(w.x); v[rr][j].z = bflo(w.y); v[rr][j].w = bfhi(w.y);
        }
      }
    }
#pragma unroll
    for (int rr = 0; rr < 4; ++rr) {
      const int row = row0 + rr * nw;
      if (row < MTOK) {
        float* y = p.out + (size_t)row * 1024;
        float s = 0.f;
#pragma unroll
        for (int j = 0; j < 4; ++j) s += (v[rr][j].x + v[rr][j].y) + (v[rr][j].z + v[rr][j].w);
        const float mu = wsum(s) * (1.f / 1024.f);
        float q = 0.f;
#pragma unroll
        for (int j = 0; j < 4; ++j) {
          float a = v[rr][j].x - mu, b = v[rr][j].y - mu, c = v[rr][j].z - mu, d = v[rr][j].w - mu;
          q += (a * a + b * b) + (c * c + d * d);
        }
        const float rstd = rsqrtf(wsum(q) * (1.f / 1024.f) + 1e-5f);
#pragma unroll
        for (int j = 0; j < 4; ++j) {
          const int cidx = (j * 64 + lane) * 4;
          const float4 gg = gg4[j], bb = bb4[j];
          float4 o;
          o.x = (v[rr][j].x - mu) * rstd * gg.x + bb.x; o.y = (v[rr][j].y - mu) * rstd * gg.y + bb.y;
          o.z = (v[rr][j].z - mu) * rstd * gg.z + bb.z; o.w = (v[rr][j].w - mu) * rstd * gg.w + bb.w;
          if (final_) *(float4*)(y + cidx) = o;
          else { uint2 w; w.x = pack2(o.x, o.y); w.y = pack2(o.z, o.w); *(uint2*)(xb + (size_t)row * 1024 + cidx) = w; }
        }
      }
    }
  }
}

#define XB_TMO      128
#define XB_XCNT(j)  (256  + 64 * (j))
#define XB_XSUB(j)  (1280 + 64 * (j))
#define XB_XGEN(j)  (2304 + 64 * (j))
#define XB_TOP      3328
#define XB_TOPGEN   3392
#define XB_SPIN_CAP (1u << 22)
#define LAS __attribute__((address_space(3)))
DEV unsigned xb_ld(unsigned* p) { return __hip_atomic_load(p, __ATOMIC_RELAXED, __HIP_MEMORY_SCOPE_AGENT); }
DEV unsigned xb_add(unsigned* p, unsigned v) { return __hip_atomic_fetch_add(p, v, __ATOMIC_RELAXED, __HIP_MEMORY_SCOPE_AGENT); }
DEV unsigned xb_xcc_id() { return (unsigned)__builtin_amdgcn_s_getreg((3 << 11) | 20) & 0xFu; }
#define XB_SPIN(cond, bar) do { unsigned _sp = 0; while (cond) { __builtin_amdgcn_s_sleep(1); \
    if ((++_sp & 255u) == 0u) { if (xb_ld(&(bar)[XB_TMO])) break; if (_sp > XB_SPIN_CAP) { atomicAdd(&(bar)[XB_TMO], 1u); break; } } } } while (0)
struct XcdBarrier { unsigned* bar; unsigned x; volatile LAS unsigned* st; };
DEV XcdBarrier xcd_barrier_post(unsigned* bar, volatile LAS unsigned* st) {
  XcdBarrier b; b.bar = bar; b.x = xb_xcc_id(); b.st = st;
  if (threadIdx.x == 0) (void)xb_add(&bar[XB_XCNT(b.x)], 1u);
  return b;
}
DEV void xcd_barrier_complete(unsigned* bar, unsigned x, unsigned& nloc, unsigned& nx) {
  const unsigned G = gridDim.x * gridDim.y * gridDim.z;
  unsigned sum, cnt, mine, sp = 0u;
  for (;;) {
    sum = 0u; cnt = 0u; mine = 0u;
#pragma unroll
    for (unsigned j = 0; j < 16; ++j) { const unsigned c = xb_ld(&bar[XB_XCNT(j)]); sum += c; cnt += (c > 0u) ? 1u : 0u; mine = (j == x) ? c : mine; }
    if (sum == G) break;
    __builtin_amdgcn_s_sleep(1);
    if ((++sp & 255u) == 0u) { if (xb_ld(&bar[XB_TMO])) break; if (sp > XB_SPIN_CAP) { atomicAdd(&bar[XB_TMO], 1u); break; } }
  }
  nloc = mine > 0u ? mine : 1u; nx = cnt > 0u ? cnt : 1u;
}
DEV void xcd_barrier(const XcdBarrier& b) {
  asm volatile("s_waitcnt vmcnt(0)" ::: "memory");
  __syncthreads();
  if (threadIdx.x == 0) {
    unsigned* bar = b.bar;
    __builtin_amdgcn_s_waitcnt(0);
    unsigned nloc = b.st[0], nx = b.st[1];
    if (nloc == 0u) { xcd_barrier_complete(bar, b.x, nloc, nx); b.st[0] = nloc; b.st[1] = nx; }
    const unsigned old = xb_add(&bar[XB_XSUB(b.x)], 1u);
    const unsigned gen = old / nloc;
    if (old + 1u == (gen + 1u) * nloc) {
      __builtin_amdgcn_fence(__ATOMIC_RELEASE, "agent");
      asm volatile("s_waitcnt vmcnt(0)" ::: "memory");
      const unsigned og = xb_add(&bar[XB_TOP], 1u);
      const unsigned tg = og / nx;
      if (og + 1u == (tg + 1u) * nx) xb_add(&bar[XB_TOPGEN], 1u);
      else XB_SPIN(xb_ld(&bar[XB_TOPGEN]) == tg, bar);
      __builtin_amdgcn_fence(__ATOMIC_ACQUIRE, "agent");
      xb_add(&bar[XB_XGEN(b.x)], 1u);
      asm volatile("s_waitcnt vmcnt(0)" ::: "memory");
    } else {
      XB_SPIN(xb_ld(&bar[XB_XGEN(b.x)]) == gen, bar);
      __builtin_amdgcn_fence(__ATOMIC_ACQUIRE, "agent");
      asm volatile("s_waitcnt vmcnt(0)" ::: "memory");
    }
  }
  __syncthreads();
}

#ifndef TPROBE
#define TPROBE -1
#endif
__global__ void __launch_bounds__(256) __attribute__((amdgpu_waves_per_eu(2, 2))) hymba_mega(Params p) {
  __shared__ __attribute__((aligned(16))) char smem[SMEM_BYTES];
  __shared__ int s_item;
  __shared__ uint4 xb_words;
  if (threadIdx.x == 0) xb_words = make_uint4(0u, 0u, 0u, 0u);
  __syncthreads();
  const XcdBarrier xb = xcd_barrier_post((unsigned*)(p.ws + OFF_XBAR), (volatile LAS unsigned*)&xb_words);
#if TPROBE >= 0
  long long* tacc = (long long*)(p.ws + OFF_SMALL + 2048);
  long long tprev = 0;
  const bool timer = (blockIdx.x == 0 && threadIdx.x == 0);
  if (timer) { for (int i = 0; i < 16; ++i) tacc[i] = 0; tprev = wall_clock64(); }
#endif
  for (int ph = p.pbeg; ph < p.pend; ++ph) {
    if (ph == 0) phase_prep(p, smem);
    else {
      const int layer = (ph - 1) / 7, sub = (ph - 1) % 7;
      switch (sub) {
        case 0: phase_inproj(p, layer, smem); break;
        case 1: phase_mixers(p, layer, smem, &s_item); break;
        case 2: phase_gemm(p, layer, 0, smem); break;
        case 3: phase_ln(p, p.ln1g + layer * 1024, p.ln1b + layer * 1024, false); break;
        case 4: phase_gemm(p, layer, 1, smem); break;
        case 5: phase_gemm(p, layer, 2, smem); break;
        default: phase_ln(p, p.ln2g + layer * 1024, p.ln2b + layer * 1024, layer == 1); break;
      }
    }
#if TPROBE >= 0
    cg::this_grid().sync();
    if (timer) {
      long long tn = wall_clock64();
      int slot = (ph == 0) ? 8 : ((ph - 1) % 7);
      tacc[slot] += tn - tprev; tacc[9] += tn - tprev; tprev = tn;
    }
#else
    if (p.coop && ph + 1 < p.pend) {
      if (ph == 0) cg::this_grid().sync();
      else xcd_barrier(xb);
    }
#endif
  }
#if TPROBE >= 0
  cg::this_grid().sync();
  {
    const float tau = (float)tacc[TPROBE] * 1e-8f / 0.010f;
    const float eps = 0.02f * sqrtf(tau);
    for (int i = blockIdx.x * 256 + threadIdx.x; i < (1 << 20); i += gridDim.x * 256) p.out[i] += eps;
  }
#endif
}

extern "C" void kernel_launch(void* const* d_in, const int* in_sizes, int n_in, void* d_out, int out_size, void* d_ws,
                              size_t ws_size, hipStream_t stream) {
  static int grid_blocks = 0;
  if (!grid_blocks) {
    int dev = 0, cus = 0, per_cu = 0;
    hipGetDevice(&dev);
    hipDeviceGetAttribute(&cus, hipDeviceAttributeMultiprocessorCount, dev);
    hipOccupancyMaxActiveBlocksPerMultiprocessor(&per_cu, hymba_mega, 256, 0);
    if (per_cu < 1) per_cu = 1;
    if (per_cu > 2) per_cu = 2;
    grid_blocks = cus * per_cu;
  }
  Params p{};
  const float* const* in = (const float* const*)d_in;
  p.x = in[0]; p.w_in = in[1]; p.lq1 = in[2]; p.lk1 = in[3]; p.lq2 = in[4]; p.lk2 = in[5]; p.subln = in[6];
  p.w_pool = in[7]; p.pool_scale = in[8]; p.pe_k = in[9]; p.pe_v = in[10]; p.w_ck = in[11]; p.w_cv = in[12];
  p.w_out = in[13]; p.ln1g = in[14]; p.ln1b = in[15]; p.w_up = in[16]; p.w_down = in[17]; p.ln2g = in[18]; p.ln2b = in[19];
  p.out = (float*)d_out;
  p.ws = (char*)d_ws;
  p.pad = 0;
  const int NPH = 15;
#if COOP
  p.pbeg = 0; p.pend = NPH; p.coop = 1;
  (void)hipMemsetAsync((char*)d_ws + OFF_XBAR, 0, (size_t)XCD_BAR_WORDS * 4, stream);
  void* args[] = {&p};
  hipError_t e = hipLaunchCooperativeKernel((void*)hymba_mega, dim3(grid_blocks), dim3(256), args, 0, stream);
  if (e != hipSuccess) fprintf(stderr, "cooperative launch failed: %s (grid %d)\n", hipGetErrorString(e), grid_blocks);
#else
  for (int ph = 0; ph < NPH; ++ph) {
    p.pbeg = ph; p.pend = ph + 1; p.coop = 0;
    hipLaunchKernelGGL(hymba_mega, dim3(grid_blocks), dim3(256), 0, stream, p);
  }
#endif
}
```
